# Optimizing an MI355X kernel written in HIP

```python
import math
import jax
import jax.numpy as jnp
from jax import lax
import numpy as np

D_MODEL = 1024
BATCH = 8
SEQ = 4096
DEPTH = 1

GRID_W = 64
CTX_LEN = 256
EPS = 1e-6
N_MOD = 6

RG_WIDTH = 512
RG_BLOCKS = 8
RG_BLOCK_DIM = RG_WIDTH // RG_BLOCKS
RG_CONV = 4
RG_C = 8.0

GDN_HEADS = 4
GDN_DK = 128
GDN_DV = 128
GDN_WIDTH = GDN_HEADS * GDN_DV
GDN_CONV = 4
GDN_CHUNK = 64

MIX_WIDTH = RG_WIDTH + GDN_WIDTH
SPLIT_POINTS = (RG_WIDTH, 2 * RG_WIDTH, 2 * RG_WIDTH + 3 * GDN_WIDTH, 2 * RG_WIDTH + 4 * GDN_WIDTH)
IN_COLS = 2 * RG_WIDTH + 4 * GDN_WIDTH + 2 * 2 * GDN_HEADS

PEER_HEADS = 8
PEER_NKEYS = 128
PEER_EXPERTS = PEER_NKEYS * PEER_NKEYS
PEER_QDIM = 256
PEER_HALF = PEER_QDIM // 2
PEER_TOPK = 16
PEER_BLOCK = 128

kernel_name = 'hybrid_rglru_gdn_peer_dit_block'


def _rmsnorm(x, g):
    xf = x.astype(jnp.float32)
    y = xf * lax.rsqrt(jnp.mean(xf * xf, axis=-1, keepdims=True) + EPS)
    return (y * g.astype(jnp.float32)).astype(x.dtype)


def _modulate(h, shift, scale):
    return h * (1 + scale) + shift


def _l2norm(t):
    return t * lax.rsqrt(jnp.sum(t * t, axis=-1, keepdims=True) + EPS)


def _dwconv_centred(x, w, b=None):
    K, C = w.shape
    left = K // 2
    y = lax.conv_general_dilated(x, w[:, None, :].astype(x.dtype), window_strides=(1,),
                                 padding=[(left, K - 1 - left)],
                                 dimension_numbers=('NWC', 'WIO', 'NWC'),
                                 feature_group_count=C)
    if b is not None:
        y = y + b.astype(x.dtype)
    return y


def _raster_to_colmajor(t, rows):
    B, L, C = t.shape
    return t.reshape(B, rows, GRID_W, C).transpose(0, 2, 1, 3).reshape(B, L, C)


def _colmajor_to_raster(t, rows):
    B, L, C = t.shape
    return t.reshape(B, GRID_W, rows, C).transpose(0, 2, 1, 3).reshape(B, L, C)


def _combine(left, right):
    a_l, b_l = left
    a_r, b_r = right
    return a_l * a_r, a_r * b_l + b_r


def _rglru_direction(xc, gate_w, gate_b, lam, h0):
    B, T, W = xc.shape
    xf = xc.astype(jnp.float32)
    xb = xf.reshape(B, T, RG_BLOCKS, RG_BLOCK_DIM)
    gates = jnp.einsum('btnd,gnde->gbtne', xb, gate_w.astype(jnp.float32)).reshape(2, B, T, W)
    gates = gates + gate_b.astype(jnp.float32)[:, None, None, :]
    r = jax.nn.sigmoid(gates[0])
    i = jax.nn.sigmoid(gates[1])
    log_a = -RG_C * r * jax.nn.softplus(-lam.astype(jnp.float32))
    a = jnp.exp(log_a)
    b = jnp.sqrt(-jnp.expm1(2.0 * log_a)) * (i * xf)
    b = b.at[:, 0].add(a[:, 0] * h0)
    _, h = lax.associative_scan(_combine, (a, b), axis=1)
    return h, h[:, -1]


def _rglru_mixer(u, gate, conv_w, conv_b, gate_w, gate_b, lam, h0_f, h0_b):
    xc = _dwconv_centred(u, conv_w, conv_b)
    h_f, s_f = _rglru_direction(xc, gate_w[0], gate_b[0], lam[0], h0_f)
    h_b, s_b = _rglru_direction(jnp.flip(xc, 1), gate_w[1], gate_b[1], lam[1], h0_b)
    y = (h_f + jnp.flip(h_b, 1)).astype(u.dtype) * jax.nn.gelu(gate)
    return y, s_f, s_b


def _gdn_chunked(q, k, v, g, beta, s0):
    B, H, T, _ = q.shape
    n = T // GDN_CHUNK
    C = GDN_CHUNK
    q, k, v = (t.reshape(B, H, n, C, t.shape[-1]) for t in (q, k, v))
    g = g.reshape(B, H, n, C)
    beta = beta.reshape(B, H, n, C)
    gc = jnp.cumsum(g, axis=-1)
    pos = jnp.arange(C)
    incl = pos[:, None] >= pos[None, :]
    strict = pos[:, None] > pos[None, :]
    diff = gc[..., :, None] - gc[..., None, :]
    decay = jnp.where(incl, jnp.exp(jnp.where(incl, diff, 0.0)), 0.0)
    kb = k * beta[..., None]
    a_strict = jnp.where(strict, jnp.einsum('bhncd,bhnsd->bhncs', kb, k) * decay, 0.0)
    rhs = jnp.concatenate([v * beta[..., None], kb * jnp.exp(gc)[..., None]], axis=-1)
    sol = lax.linalg.triangular_solve(a_strict, rhs, left_side=True, lower=True, unit_diagonal=True)
    w_val = sol[..., :GDN_DV]
    k_cum = sol[..., GDN_DV:]
    attn = jnp.where(incl, jnp.einsum('bhncd,bhnsd->bhncs', q, k) * decay, 0.0)
    xs = tuple(jnp.moveaxis(t, 2, 0) for t in (q, k, w_val, k_cum, attn, gc))

    def step(S, inp):
        qi, ki, wi, kci, ai, gi = inp
        v_new = wi - jnp.einsum('bhcd,bhde->bhce', kci, S)
        o = jnp.einsum('bhcd,bhde->bhce', qi * jnp.exp(gi)[..., None], S) + jnp.einsum('bhcs,bhse->bhce', ai, v_new)
        g_last = gi[..., -1]
        S = S * jnp.exp(g_last)[..., None, None] + jnp.einsum('bhcd,bhce->bhde', ki * jnp.exp(g_last[..., None] - gi)[..., None], v_new)
        return S, o

    s_fin, o = lax.scan(step, s0, xs)
    o = jnp.moveaxis(o, 0, 2).reshape(B, H, T, GDN_DV)
    return o, s_fin


def _gdn_mixer(qkv, z, ab, conv_w, a_log, dt_bias, norm_g, s0_f, s0_b):
    B, T, _ = qkv.shape
    f32 = jnp.float32
    qkv = jax.nn.silu(_dwconv_centred(qkv, conv_w)).astype(f32)
    q, k, v = jnp.split(qkv, 3, axis=-1)
    heads = lambda t: t.reshape(B, T, GDN_HEADS, -1).transpose(0, 2, 1, 3)
    q = _l2norm(heads(q)) * (GDN_DK ** -0.5)
    k = _l2norm(heads(k))
    v = heads(v)
    ab = ab.astype(f32).reshape(B, T, 2, 2, GDN_HEADS).transpose(2, 3, 0, 4, 1)
    g = -jnp.exp(a_log.astype(f32))[:, None, :, None] * jax.nn.softplus(ab[:, 0] + dt_bias.astype(f32)[:, None, :, None])
    beta = jax.nn.sigmoid(ab[:, 1])
    o_f, s_f = _gdn_chunked(q, k, v, g[0], beta[0], s0_f)
    fl = lambda t: jnp.flip(t, 2)
    o_b, s_b = _gdn_chunked(fl(q), fl(k), fl(v), fl(g[1]), fl(beta[1]), s0_b)
    o = (o_f + fl(o_b)).transpose(0, 2, 1, 3)
    o = _rmsnorm(o, norm_g) * jax.nn.silu(z.astype(f32).reshape(B, T, GDN_HEADS, GDN_DV))
    return o.reshape(B, T, GDN_WIDTH).astype(z.dtype), s_f, s_b


def _mix(p, rows, mix_params, states):
    rg_conv_w, rg_conv_b, rg_gate_w, rg_gate_b, rg_lambda, gdn_conv_w, gdn_a_log, gdn_dt_bias, gdn_norm_g = mix_params
    rg_h0_f, rg_h0_b, gdn_s0_f, gdn_s0_b = states
    rg_u, rg_gate, qkv, z, ab = jnp.split(p, list(SPLIT_POINTS), axis=-1)
    if rows is not None:
        qkv = _raster_to_colmajor(qkv, rows)
        z = _raster_to_colmajor(z, rows)
        ab = _raster_to_colmajor(ab, rows)
    y_rg, rg_f, rg_b = _rglru_mixer(rg_u, rg_gate, rg_conv_w, rg_conv_b, rg_gate_w, rg_gate_b, rg_lambda, rg_h0_f, rg_h0_b)
    y_gdn, s_f, s_b = _gdn_mixer(qkv, z, ab, gdn_conv_w, gdn_a_log, gdn_dt_bias, gdn_norm_g, gdn_s0_f, gdn_s0_b)
    if rows is not None:
        y_gdn = _colmajor_to_raster(y_gdn, rows)
    return jnp.concatenate([y_rg, y_gdn], axis=-1), (rg_f, rg_b, s_f, s_b)


def _peer(h, wq, keys, u, v):
    B, T, D = h.shape
    blocks = h.reshape(B * T // PEER_BLOCK, PEER_BLOCK, D)

    def one_block(hb):
        q = (hb @ wq).astype(jnp.float32).reshape(PEER_BLOCK, PEER_HEADS, 2, PEER_HALF)
        s = jnp.einsum('phxd,xkd->phxk', q, keys.astype(jnp.float32))
        s1, i1 = lax.top_k(s[:, :, 0], PEER_TOPK)
        s2, i2 = lax.top_k(s[:, :, 1], PEER_TOPK)
        cand_s = (s1[..., :, None] + s2[..., None, :]).reshape(PEER_BLOCK, PEER_HEADS, PEER_TOPK * PEER_TOPK)
        cand_i = (i1[..., :, None] * PEER_NKEYS + i2[..., None, :]).reshape(PEER_BLOCK, PEER_HEADS, PEER_TOPK * PEER_TOPK)
        top_s, pos = lax.top_k(cand_s, PEER_TOPK)
        idx = jnp.take_along_axis(cand_i, pos, axis=-1)
        gate = jax.nn.softmax(top_s, axis=-1).astype(hb.dtype)
        u_e = jnp.take(u, idx, axis=0)
        v_e = jnp.take(v, idx, axis=0)
        act = jax.nn.gelu(jnp.einsum('pd,phkd->phk', hb, u_e))
        return jnp.einsum('phk,phkd->pd', gate * act, v_e)

    return lax.map(one_block, blocks).reshape(B, T, D)


def setup_inputs(seed: int = 0) -> dict:
    key = jax.random.key(seed)
    ks = jax.random.split(key, 24)
    f32 = jnp.float32
    D = D_MODEL
    nrm = lambda k, shape, s: jax.random.normal(k, shape, f32) * s
    x = nrm(ks[0], (BATCH, SEQ, D), 1.0)
    c = nrm(ks[1], (BATCH, D), 1.0)
    ctx = nrm(ks[2], (BATCH, CTX_LEN, D), 1.0)
    c_ctx = nrm(ks[3], (D,), 1.0)
    w_mod = nrm(ks[4], (DEPTH, D, N_MOD * D), 0.5 * D ** -0.5)
    b_mod = nrm(ks[5], (DEPTH, N_MOD * D), 0.01)
    norm1_g = 1.0 + nrm(ks[6], (DEPTH, D), 0.01)
    norm2_g = 1.0 + nrm(ks[7], (DEPTH, D), 0.01)
    w_in = nrm(ks[8], (DEPTH, D, IN_COLS), D ** -0.5)
    rg_conv_w = nrm(ks[9], (DEPTH, RG_CONV, RG_WIDTH), RG_CONV ** -0.5)
    rg_conv_b = nrm(ks[10], (DEPTH, RG_WIDTH), 0.01)
    rg_gate_w = nrm(ks[11], (DEPTH, 2, 2, RG_BLOCKS, RG_BLOCK_DIM, RG_BLOCK_DIM), RG_BLOCK_DIM ** -0.5)
    rg_gate_b = nrm(ks[12], (DEPTH, 2, 2, RG_WIDTH), 0.01)
    a_pow = jax.random.uniform(ks[13], (DEPTH, 2, RG_WIDTH), f32, 0.9, 0.999)
    a0 = a_pow ** (1.0 / RG_C)
    rg_lambda = jnp.log(a0) - jnp.log1p(-a0)
    gdn_conv_w = nrm(ks[14], (DEPTH, GDN_CONV, 3 * GDN_WIDTH), GDN_CONV ** -0.5)
    gdn_a_log = jnp.log(jax.random.uniform(ks[15], (DEPTH, 2, GDN_HEADS), f32, 1.0, 16.0))
    dt = jnp.exp(jax.random.uniform(ks[16], (DEPTH, 2, GDN_HEADS), f32, math.log(1e-3), math.log(1e-1)))
    gdn_dt_bias = dt + jnp.log(-jnp.expm1(-dt))
    gdn_norm_g = 1.0 + nrm(ks[17], (DEPTH, GDN_DV), 0.01)
    w_out = nrm(ks[18], (DEPTH, MIX_WIDTH, D), MIX_WIDTH ** -0.5)
    peer_wq = nrm(ks[19], (DEPTH, D, PEER_HEADS * PEER_QDIM), D ** -0.5)
    peer_keys = nrm(ks[20], (DEPTH, 2, PEER_NKEYS, PEER_HALF), PEER_HALF ** -0.5)
    peer_u = nrm(ks[21], (DEPTH, PEER_EXPERTS, D), D ** -0.5)
    peer_v = nrm(ks[22], (DEPTH, PEER_EXPERTS, D), PEER_HEADS ** -0.5)
    final_g = 1.0 + nrm(ks[23], (D,), 0.01)
    return {'x': x, 'c': c, 'ctx': ctx, 'c_ctx': c_ctx, 'w_mod': w_mod, 'b_mod': b_mod,
            'norm1_g': norm1_g, 'norm2_g': norm2_g, 'w_in': w_in,
            'rg_conv_w': rg_conv_w, 'rg_conv_b': rg_conv_b, 'rg_gate_w': rg_gate_w,
            'rg_gate_b': rg_gate_b, 'rg_lambda': rg_lambda, 'gdn_conv_w': gdn_conv_w,
            'gdn_a_log': gdn_a_log, 'gdn_dt_bias': gdn_dt_bias, 'gdn_norm_g': gdn_norm_g,
            'w_out': w_out, 'peer_wq': peer_wq, 'peer_keys': peer_keys, 'peer_u': peer_u,
            'peer_v': peer_v, 'final_g': final_g}


def reference(x, c, ctx, c_ctx, w_mod, b_mod, norm1_g, norm2_g, w_in, rg_conv_w, rg_conv_b,
              rg_gate_w, rg_gate_b, rg_lambda, gdn_conv_w, gdn_a_log, gdn_dt_bias, gdn_norm_g,
              w_out, peer_wq, peer_keys, peer_u, peer_v, final_g):
    B, L, _ = x.shape
    rows = L // GRID_W
    zero_states = (jnp.zeros((B, RG_WIDTH), jnp.float32), jnp.zeros((B, RG_WIDTH), jnp.float32),
                   jnp.zeros((B, GDN_HEADS, GDN_DK, GDN_DV), jnp.float32),
                   jnp.zeros((B, GDN_HEADS, GDN_DK, GDN_DV), jnp.float32))
    for l in range(DEPTH):
        mod_lat = (jax.nn.silu(c) @ w_mod[l] + b_mod[l])[:, None, :]
        mod_ctx = (jax.nn.silu(c_ctx) @ w_mod[l] + b_mod[l])[None, None, :]
        sh1, sc1, gt1, sh2, sc2, gt2 = jnp.split(mod_lat, N_MOD, axis=-1)
        csh1, csc1, cgt1, csh2, csc2, cgt2 = jnp.split(mod_ctx, N_MOD, axis=-1)
        mix_params = (rg_conv_w[l], rg_conv_b[l], rg_gate_w[l], rg_gate_b[l], rg_lambda[l],
                      gdn_conv_w[l], gdn_a_log[l], gdn_dt_bias[l], gdn_norm_g[l])
        p_ctx = _modulate(_rmsnorm(ctx, norm1_g[l]), csh1, csc1) @ w_in[l]
        y_ctx, ctx_states = _mix(p_ctx, None, mix_params, zero_states)
        p_lat = _modulate(_rmsnorm(x, norm1_g[l]), sh1, sc1) @ w_in[l]
        y_lat, _ = _mix(p_lat, rows, mix_params, ctx_states)
        x = x + gt1 * (y_lat @ w_out[l])
        x = x + gt2 * _peer(_modulate(_rmsnorm(x, norm2_g[l]), sh2, sc2), peer_wq[l], peer_keys[l], peer_u[l], peer_v[l])
        if l < DEPTH - 1:
            ctx = ctx + cgt1 * (y_ctx @ w_out[l])
            ctx = ctx + cgt2 * _peer(_modulate(_rmsnorm(ctx, norm2_g[l]), csh2, csc2), peer_wq[l], peer_keys[l], peer_u[l], peer_v[l])
    return _rmsnorm(x, final_g)
```

```cpp
#include <hip/hip_runtime.h>
#include <hip/hip_cooperative_groups.h>
#include <cstdio>
namespace cg = cooperative_groups;

#define NT 512
typedef __attribute__((ext_vector_type(8))) short bf16x8;
typedef __attribute__((ext_vector_type(16))) float f32x16;
typedef __attribute__((ext_vector_type(4))) float f32x4;
typedef unsigned short bf16_t;
typedef unsigned u32x4 __attribute__((ext_vector_type(4)));

#define MFMA32(a, b, c) __builtin_amdgcn_mfma_f32_32x32x16_bf16((a), (b), (c), 0, 0, 0)
#define MFMA16(a, b, c) __builtin_amdgcn_mfma_f32_16x16x32_bf16((a), (b), (c), 0, 0, 0)

constexpr int RLAT = 32768, RALL = 34816;
constexpr int LDS_BYTES = 155648;
constexpr int NCHUNK = 4352;

constexpr size_t OFF_MOD = 0;
constexpr size_t OFF_WIN = OFF_MOD + 221184;
constexpr size_t OFF_WOUT = OFF_WIN + 6815744;
constexpr size_t OFF_WQ = OFF_WOUT + 2097152;
constexpr size_t OFF_KEYS = OFF_WQ + 4194304;
constexpr size_t OFF_PRG = OFF_KEYS + 65536;
constexpr size_t OFF_PQKV = OFF_PRG + 71303168;
constexpr size_t OFF_PZ = OFF_PQKV + 106954752;
constexpr size_t OFF_PAB = OFF_PZ + 35651584;
constexpr size_t OFF_QG = OFF_PAB + 2228224;
constexpr size_t OFF_KDT = OFF_QG + 71303168;
constexpr size_t OFF_KC = OFF_KDT + 71303168;
constexpr size_t OFF_EGL = OFF_KC + 71303168;
constexpr size_t OFF_H = OFF_EGL + 17408;
constexpr size_t WS_END = OFF_H + 67108864;
constexpr size_t OUT_WV = 0;
constexpr size_t OUT_AT = 71303168;

struct Params {
  const float *x, *c, *ctx, *c_ctx, *w_mod, *b_mod, *norm1_g, *norm2_g, *w_in, *rg_conv_w, *rg_conv_b,
      *rg_gate_w, *rg_gate_b, *rg_lambda, *gdn_conv_w, *gdn_a_log, *gdn_dt_bias, *gdn_norm_g, *w_out,
      *peer_wq, *peer_keys, *peer_u, *peer_v, *final_g;
  float* out;
  unsigned char* ws;
  int ph_lo, ph_hi;
  int rep_mask, pad_;
};

__device__ __forceinline__ bf16_t f2bf(float f) {
  unsigned u = __float_as_uint(f);
  u += 0x7fffu + ((u >> 16) & 1u);
  return (bf16_t)(u >> 16);
}
__device__ __forceinline__ float bf2f(bf16_t b) { return __uint_as_float(((unsigned)b) << 16); }
__device__ __forceinline__ unsigned pack2(float a, float b) { return (unsigned)f2bf(a) | ((unsigned)f2bf(b) << 16); }
__device__ __forceinline__ float wave_sum(float v) {
#pragma unroll
  for (int o = 32; o > 0; o >>= 1) v += __shfl_xor(v, o, 64);
  return v;
}
__device__ __forceinline__ float sigmoidf_(float x) { return 1.f / (1.f + __expf(-x)); }
__device__ __forceinline__ float siluf_(float x) { return x / (1.f + __expf(-x)); }
__device__ __forceinline__ float softplusf_(float x) { return fmaxf(x, 0.f) + log1pf(__expf(-fabsf(x))); }
__device__ __forceinline__ float gelu_tanh(float x) {
  float y = 0.7978845608028654f * (x + 0.044715f * x * x * x);
  return 0.5f * x * (1.f + tanhf(y));
}

__device__ void transpose_tile(const float* W, int N, bf16_t* Wt, int kt, int nt, float* tile) {
  const int tid = threadIdx.x;
  const int k0 = kt * 64, n0 = nt * 64;
#pragma unroll
  for (int i = 0; i < 8; ++i) {
    int r = i * 8 + (tid >> 6), cc = tid & 63, n = n0 + cc;
    tile[r * 65 + cc] = (n < N) ? W[(size_t)(k0 + r) * N + n] : 0.f;
  }
  __syncthreads();
#pragma unroll
  for (int i = 0; i < 8; ++i) {
    int r = i * 8 + (tid >> 6), cc = tid & 63;
    Wt[(size_t)(n0 + r) * 1024 + k0 + cc] = f2bf(tile[cc * 65 + r]);
  }
  __syncthreads();
}

__device__ void phase0(const Params& p, unsigned char* smem) {
  const int tid = threadIdx.x;
  float* mod = (float*)(p.ws + OFF_MOD);
  const int nitems = 96 + 832 + 256 + 512 + 1;
  for (int item = blockIdx.x; item < nitems; item += gridDim.x) {
    if (item < 96) {
      float* sc = (float*)smem;
      float* red = sc + 9 * 1024;
      for (int i = tid; i < 9 * 1024; i += NT) {
        int row = i >> 10, k = i & 1023;
        float v = row < 8 ? p.c[row * 1024 + k] : p.c_ctx[k];
        sc[i] = siluf_(v);
      }
      __syncthreads();
      const int w = tid >> 6, lane = tid & 63;
      const int col = item * 64 + lane;
      float acc[9];
#pragma unroll
      for (int r = 0; r < 9; ++r) acc[r] = 0.f;
      const float* wp = p.w_mod + (size_t)(w * 128) * 6144 + col;
#pragma unroll 8
      for (int k = 0; k < 128; ++k) {
        float wv = wp[(size_t)k * 6144];
#pragma unroll
        for (int r = 0; r < 9; ++r) acc[r] += sc[r * 1024 + w * 128 + k] * wv;
      }
#pragma unroll
      for (int r = 0; r < 9; ++r) red[(w * 9 + r) * 64 + lane] = acc[r];
      __syncthreads();
      for (int i = tid; i < 9 * 64; i += NT) {
        int r = i >> 6, l = i & 63;
        float s = 0.f;
        for (int ww = 0; ww < 8; ++ww) s += red[(ww * 9 + r) * 64 + l];
        int cc = item * 64 + l;
        mod[r * 6144 + cc] = s + p.b_mod[cc];
      }
      __syncthreads();
    } else if (item < 96 + 832) {
      int it = item - 96;
      transpose_tile(p.w_in, 3088, (bf16_t*)(p.ws + OFF_WIN), it & 15, it >> 4, (float*)smem);
    } else if (item < 96 + 832 + 256) {
      int it = item - 928;
      transpose_tile(p.w_out, 1024, (bf16_t*)(p.ws + OFF_WOUT), it & 15, it >> 4, (float*)smem);
    } else if (item < 96 + 832 + 256 + 512) {
      int it = item - 1184;
      transpose_tile(p.peer_wq, 2048, (bf16_t*)(p.ws + OFF_WQ), it & 15, it >> 4, (float*)smem);
    } else {
      bf16_t* kb = (bf16_t*)(p.ws + OFF_KEYS);
      for (int i = tid; i < 2 * 128 * 128; i += NT) kb[i] = f2bf(p.peer_keys[i]);
    }
  }
}

__device__ void norm_mod_rows(const float* src_lat, const float* src_ctx, int nrows, const float* g,
                              const float* mod, int sh_off, int sc_off, bf16_t* dst) {
  const int lane = threadIdx.x & 63, w = threadIdx.x >> 6;
  for (int row = blockIdx.x * 8 + w; row < nrows; row += gridDim.x * 8) {
    const float* xr = row < RLAT ? src_lat + (size_t)row * 1024 : src_ctx + (size_t)(row - RLAT) * 1024;
    const int bb = row < RLAT ? (row >> 12) : 8;
    float4 v[4];
    float ss = 0.f;
#pragma unroll
    for (int m = 0; m < 4; ++m) {
      v[m] = ((const float4*)xr)[m * 64 + lane];
      ss += v[m].x * v[m].x + v[m].y * v[m].y + v[m].z * v[m].z + v[m].w * v[m].w;
    }
    ss = wave_sum(ss);
    const float rstd = rsqrtf(ss * (1.f / 1024.f) + 1e-6f);
#pragma unroll
    for (int m = 0; m < 4; ++m) {
      const int col = (m * 64 + lane) * 4;
      float4 gg = *(const float4*)(g + col);
      float4 sh = *(const float4*)(mod + bb * 6144 + sh_off + col);
      float4 sc = *(const float4*)(mod + bb * 6144 + sc_off + col);
      float y0 = v[m].x * rstd * gg.x * (1.f + sc.x) + sh.x;
      float y1 = v[m].y * rstd * gg.y * (1.f + sc.y) + sh.y;
      float y2 = v[m].z * rstd * gg.z * (1.f + sc.z) + sh.z;
      float y3 = v[m].w * rstd * gg.w * (1.f + sc.w) + sh.w;
      uint2 o;
      o.x = pack2(y0, y1);
      o.y = pack2(y2, y3);
      *(uint2*)(dst + (size_t)row * 1024 + col) = o;
    }
  }
}

__device__ __forceinline__ void gemm_tile(const bf16_t* A, const bf16_t* Bt, f32x16 (&acc)[2][2], unsigned char* smem) {
  const int tid = threadIdx.x, lane = tid & 63, w = tid >> 6;
  const int wm = w >> 1, wn = w & 1;
  const int r = lane & 31, h = lane >> 5;
  u32x4 ra0, ra1, ra2, ra3, rb0, rb1;
#pragma unroll
  for (int i = 0; i < 2; ++i)
#pragma unroll
    for (int j = 0; j < 2; ++j)
#pragma unroll
      for (int q = 0; q < 16; ++q) acc[i][j][q] = 0.f;
  const int srow = tid >> 3, scol = (tid & 7) * 8;
  const bf16_t* Ag = A + (size_t)srow * 1024 + scol;
  const bf16_t* Bg = Bt + (size_t)srow * 1024 + scol;
  const int soff = (srow * 72 + scol) * 2;
#define GLOAD(kt_)                                                   \
  ra0 = *(const u32x4*)(Ag + (kt_) * 64);                            \
  ra1 = *(const u32x4*)(Ag + (size_t)64 * 1024 + (kt_) * 64);        \
  ra2 = *(const u32x4*)(Ag + (size_t)128 * 1024 + (kt_) * 64);       \
  ra3 = *(const u32x4*)(Ag + (size_t)192 * 1024 + (kt_) * 64);       \
  rb0 = *(const u32x4*)(Bg + (kt_) * 64);                            \
  rb1 = *(const u32x4*)(Bg + (size_t)64 * 1024 + (kt_) * 64);
#define SSTORE(buf_)                                                        \
  {                                                                         \
    unsigned char* sb_ = smem + (buf_) * 55296 + soff;                      \
    *(u32x4*)(sb_) = ra0;                                                   \
    *(u32x4*)(sb_ + 64 * 144) = ra1;                                        \
    *(u32x4*)(sb_ + 128 * 144) = ra2;                                       \
    *(u32x4*)(sb_ + 192 * 144) = ra3;                                       \
    *(u32x4*)(sb_ + 36864) = rb0;                                           \
    *(u32x4*)(sb_ + 36864 + 64 * 144) = rb1;                                \
  }
  GLOAD(0)
  __syncthreads();
  SSTORE(0)
  GLOAD(1)
  __syncthreads();
#define KSTEP(ks)                                                                          \
  {                                                                                        \
    bf16x8 a0 = *(const bf16x8*)(As + (wm * 64 + r) * 72 + (ks) * 16 + h * 8);             \
    bf16x8 a1 = *(const bf16x8*)(As + (wm * 64 + 32 + r) * 72 + (ks) * 16 + h * 8);        \
    bf16x8 b0 = *(const bf16x8*)(Bs + (wn * 64 + r) * 72 + (ks) * 16 + h * 8);             \
    bf16x8 b1 = *(const bf16x8*)(Bs + (wn * 64 + 32 + r) * 72 + (ks) * 16 + h * 8);        \
    acc[0][0] = MFMA32(a0, b0, acc[0][0]);                                                 \
    acc[0][1] = MFMA32(a0, b1, acc[0][1]);                                                 \
    acc[1][0] = MFMA32(a1, b0, acc[1][0]);                                                 \
    acc[1][1] = MFMA32(a1, b1, acc[1][1]);                                                 \
  }
  for (int kt = 0; kt < 16; ++kt) {
    const int cur = kt & 1;
    const bf16_t* As = (const bf16_t*)(smem + cur * 55296);
    const bf16_t* Bs = (const bf16_t*)(smem + cur * 55296 + 36864);
    KSTEP(0)
    __builtin_amdgcn_sched_barrier(0);
    if (kt + 1 < 16) SSTORE(cur ^ 1)
    __builtin_amdgcn_sched_barrier(0);
    if (kt + 2 < 16) { GLOAD(kt + 2) }
    __builtin_amdgcn_sched_barrier(0);
    KSTEP(1)
    KSTEP(2)
    KSTEP(3)
    __syncthreads();
  }
#undef KSTEP
#undef GLOAD
#undef SSTORE
}

__device__ __forceinline__ void store_tile_bf16(const f32x16 (&acc)[2][2], unsigned char* smem, bf16_t* dst, size_t ld) {
  const int lane = threadIdx.x & 63, w = threadIdx.x >> 6;
  const int r = lane & 31, h = lane >> 5;
  bf16_t* Cw = (bf16_t*)(smem + w * 9216);
#pragma unroll
  for (int i = 0; i < 2; ++i)
#pragma unroll
    for (int j = 0; j < 2; ++j)
#pragma unroll
      for (int q = 0; q < 16; ++q)
        Cw[(i * 32 + (q & 3) + 8 * (q >> 2) + 4 * h) * 72 + j * 32 + r] = f2bf(acc[i][j][q]);
#pragma unroll
  for (int it = 0; it < 8; ++it) {
    const int row = (lane >> 3) + 8 * it, seg = lane & 7;
    const u32x4 v = *(const u32x4*)(Cw + row * 72 + seg * 8);
    *(u32x4*)(dst + (size_t)row * ld + seg * 8) = v;
  }
}

__device__ __forceinline__ void gemm_tile256(const bf16_t* A, const bf16_t* Bt, f32x16 (&acc)[4][2], unsigned char* smem) {
  const int tid = threadIdx.x, lane = tid & 63, w = tid >> 6;
  const int wm = w >> 2, wn = w & 3;
  const int r = lane & 31, h = lane >> 5;
  u32x4 ra0, ra1, ra2, ra3, rb0, rb1, rb2, rb3;
#pragma unroll
  for (int i = 0; i < 4; ++i)
#pragma unroll
    for (int j = 0; j < 2; ++j)
#pragma unroll
      for (int q = 0; q < 16; ++q) acc[i][j][q] = 0.f;
  const int srow = tid >> 3, scol = (tid & 7) * 8;
  const bf16_t* Ag = A + (size_t)srow * 1024 + scol;
  const bf16_t* Bg = Bt + (size_t)srow * 1024 + scol;
  const int soff = (srow * 72 + scol) * 2;
#define GLOAD(kt_)                                                   \
  ra0 = *(const u32x4*)(Ag + (kt_) * 64);                            \
  ra1 = *(const u32x4*)(Ag + (size_t)64 * 1024 + (kt_) * 64);        \
  ra2 = *(const u32x4*)(Ag + (size_t)128 * 1024 + (kt_) * 64);       \
  ra3 = *(const u32x4*)(Ag + (size_t)192 * 1024 + (kt_) * 64);       \
  rb0 = *(const u32x4*)(Bg + (kt_) * 64);                            \
  rb1 = *(const u32x4*)(Bg + (size_t)64 * 1024 + (kt_) * 64);        \
  rb2 = *(const u32x4*)(Bg + (size_t)128 * 1024 + (kt_) * 64);       \
  rb3 = *(const u32x4*)(Bg + (size_t)192 * 1024 + (kt_) * 64);
#define SSTORE(buf_)                                                        \
  {                                                                         \
    unsigned char* sb_ = smem + (buf_) * 73728 + soff;                      \
    *(u32x4*)(sb_) = ra0;                                                   \
    *(u32x4*)(sb_ + 64 * 144) = ra1;                                        \
    *(u32x4*)(sb_ + 128 * 144) = ra2;                                       \
    *(u32x4*)(sb_ + 192 * 144) = ra3;                                       \
    *(u32x4*)(sb_ + 36864) = rb0;                                           \
    *(u32x4*)(sb_ + 36864 + 64 * 144) = rb1;                                \
    *(u32x4*)(sb_ + 36864 + 128 * 144) = rb2;                               \
    *(u32x4*)(sb_ + 36864 + 192 * 144) = rb3;                               \
  }
#define KSTEP(ks)                                                                          \
  {                                                                                        \
    bf16x8 b0 = *(const bf16x8*)(Bs + (wn * 64 + r) * 72 + (ks) * 16 + h * 8);             \
    bf16x8 b1 = *(const bf16x8*)(Bs + (wn * 64 + 32 + r) * 72 + (ks) * 16 + h * 8);        \
    _Pragma("unroll") for (int i_ = 0; i_ < 4; ++i_) {                                     \
      bf16x8 a_ = *(const bf16x8*)(As + (wm * 128 + i_ * 32 + r) * 72 + (ks) * 16 + h * 8); \
      acc[i_][0] = MFMA32(a_, b0, acc[i_][0]);                                             \
      acc[i_][1] = MFMA32(a_, b1, acc[i_][1]);                                             \
    }                                                                                      \
  }
  GLOAD(0)
  __syncthreads();
  SSTORE(0)
  GLOAD(1)
  __syncthreads();
  for (int kt = 0; kt < 16; ++kt) {
    const int cur = kt & 1;
    const bf16_t* As = (const bf16_t*)(smem + cur * 73728);
    const bf16_t* Bs = (const bf16_t*)(smem + cur * 73728 + 36864);
    KSTEP(0)
    __builtin_amdgcn_sched_barrier(0);
    if (kt + 1 < 16) SSTORE(cur ^ 1)
    __builtin_amdgcn_sched_barrier(0);
    if (kt + 2 < 16) { GLOAD(kt + 2) }
    __builtin_amdgcn_sched_barrier(0);
    KSTEP(1)
    KSTEP(2)
    KSTEP(3)
    __syncthreads();
  }
#undef KSTEP
#undef GLOAD
#undef SSTORE
}

__device__ __forceinline__ void store_half_bf16(const f32x16& a00, const f32x16& a01, const f32x16& a10, const f32x16& a11,
                                                unsigned char* smem, bf16_t* dst, size_t ld) {
  const int lane = threadIdx.x & 63, w = threadIdx.x >> 6;
  const int r = lane & 31, h = lane >> 5;
  bf16_t* Cw = (bf16_t*)(smem + w * 9216);
#pragma unroll
  for (int q = 0; q < 16; ++q) {
    const int rr = (q & 3) + 8 * (q >> 2) + 4 * h;
    Cw[rr * 72 + r] = f2bf(a00[q]);
    Cw[rr * 72 + 32 + r] = f2bf(a01[q]);
    Cw[(32 + rr) * 72 + r] = f2bf(a10[q]);
    Cw[(32 + rr) * 72 + 32 + r] = f2bf(a11[q]);
  }
#pragma unroll
  for (int it = 0; it < 8; ++it) {
    const int row = (lane >> 3) + 8 * it, seg = lane & 7;
    const u32x4 v = *(const u32x4*)(Cw + row * 72 + seg * 8);
    *(u32x4*)(dst + (size_t)row * ld + seg * 8) = v;
  }
}

__device__ void phase_inproj(const Params& p, unsigned char* smem) {
  const bf16_t* XN = (const bf16_t*)(p.ws + OFF_KC);
  const bf16_t* WT = (const bf16_t*)(p.ws + OFF_WIN);
  bf16_t* PRG = (bf16_t*)(p.ws + OFF_PRG);
  bf16_t* PQKV = (bf16_t*)(p.ws + OFF_PQKV);
  bf16_t* PZ = (bf16_t*)(p.ws + OFF_PZ);
  float* PAB = (float*)(p.ws + OFF_PAB);
  const int lane = threadIdx.x & 63, w = threadIdx.x >> 6;
  const int wm = w >> 2, wn = w & 3, r = lane & 31, h = lane >> 5;
  const bool swz = (gridDim.x == 256);
  const int xcd = blockIdx.x & 7;
  const int ntiles = swz ? 17 * 13 : 136 * 13;
  for (int k = swz ? (blockIdx.x >> 3) : blockIdx.x; k < ntiles; k += swz ? 32 : gridDim.x) {
    const int mt = swz ? xcd + 8 * (k / 13) : k / 13, nt = k % 13;
    const int m0 = mt * 256, n0 = nt * 256;
    f32x16 acc[4][2];
    gemm_tile256(XN + (size_t)m0 * 1024, WT + (size_t)n0 * 1024, acc, smem);
    const int nc = n0 + wn * 64;
    if (nc < 3072) {
      bf16_t* dst; size_t ld;
      if (nc < 1024) { dst = PRG + nc; ld = 1024; }
      else if (nc < 2560) { dst = PQKV + (nc - 1024); ld = 1536; }
      else { dst = PZ + (nc - 2560); ld = 512; }
      dst += (size_t)(m0 + wm * 128) * ld;
      store_half_bf16(acc[0][0], acc[0][1], acc[1][0], acc[1][1], smem, dst, ld);
      store_half_bf16(acc[2][0], acc[2][1], acc[3][0], acc[3][1], smem, dst + 64 * ld, ld);
    } else if (nc == 3072 && r < 16) {
#pragma unroll
      for (int i = 0; i < 4; ++i)
#pragma unroll
        for (int q = 0; q < 16; ++q) {
          const size_t grow = m0 + wm * 128 + i * 32 + (q & 3) + 8 * (q >> 2) + 4 * h;
          PAB[grow * 16 + r] = acc[i][0][q];
        }
    }
  }
}

__device__ __forceinline__ int chunk_id(int dir, int b, int h, int ci) { return ((dir * 8 + b) * 4 + h) * 68 + ci; }

typedef __attribute__((address_space(3))) const float lds_cf;
typedef __attribute__((address_space(3))) const bf16_t lds_cb;
typedef __attribute__((address_space(3))) const f32x4 lds_cf4;
typedef __attribute__((address_space(3))) bf16_t lds_b;
template <int DIR, int SRC>
__device__ __forceinline__ void solve_col(lds_cf* A_, lds_cf* vcol, lds_cb* kcol, lds_cf* scale, lds_b* dst) {
  asm volatile("" : "+v"(A_), "+v"(vcol), "+v"(kcol), "+v"(scale), "+v"(dst));
  float sol[64];
#pragma unroll
  for (int i = 0; i < 64; ++i) {
    const int ti = DIR ? 63 - i : i;
    float rv;
    if (SRC == 0) rv = vcol[ti * 128] * scale[i];
    else rv = bf2f(kcol[ti * 136]) * scale[i];
#pragma unroll
    for (int s4 = 0; s4 < (i + 3) / 4; ++s4) {
      const f32x4 a4 = *(lds_cf4*)(A_ + i * 64 + s4 * 4);
      if (s4 * 4 + 0 < i) rv -= a4[0] * sol[s4 * 4 + 0];
      if (s4 * 4 + 1 < i) rv -= a4[1] * sol[s4 * 4 + 1];
      if (s4 * 4 + 2 < i) rv -= a4[2] * sol[s4 * 4 + 2];
      if (s4 * 4 + 3 < i) rv -= a4[3] * sol[s4 * 4 + 3];
    }
    sol[i] = rv;
    dst[i * 256] = f2bf(rv);
    __builtin_amdgcn_sched_barrier(0);
  }
}

__device__ __forceinline__ void prepass_preload(const Params& p, int item, u32x4 (&pr)[7], float (&pf)[5]) {
  int tid = threadIdx.x;
  asm volatile("" : "+v"(tid));
  const bool lat = item < 2048;
  int b, c, h;
  if (lat) { b = item >> 8; c = (item >> 2) & 63; h = item & 3; }
  else { int it = item - 2048; b = it >> 4; c = (it >> 2) & 3; h = it & 3; }
  const int Tseq = lat ? 4096 : 256;
  const bf16_t* PQKV = (const bf16_t*)(p.ws + OFF_PQKV);
  const float* PAB = (const float*)(p.ws + OFF_PAB);
#pragma unroll
  for (int i = 0; i < 7; ++i) {
    const int s = tid + i * NT;
    const int rr = s / 48, q = s % 48;
    const int part = q >> 4, sg = q & 15;
    const int j = c * 64 - 2 + rr;
    u32x4 val = {0u, 0u, 0u, 0u};
    if (s < 67 * 48 && j >= 0 && j < Tseq) {
      const size_t grow = lat ? (size_t)b * 4096 + (size_t)((j & 63) * 64 + (j >> 6)) : (size_t)RLAT + b * 256 + j;
      val = *(const u32x4*)(PQKV + grow * 1536 + part * 512 + h * 128 + sg * 8);
    }
    pr[i] = val;
  }
  pf[0] = 0.f;
}

__device__ __forceinline__ void gdn_prepass_item(const Params& p, int item, int next_item, unsigned char* smem, u32x4 (&pr)[7], float (&pf)[5]) {
  const int tid = threadIdx.x, lane = tid & 63, w = tid >> 6;
  const bool lat = item < 2048;
  int b, c, h;
  if (lat) { b = item >> 8; c = (item >> 2) & 63; h = item & 3; }
  else { int it = item - 2048; b = it >> 4; c = (it >> 2) & 3; h = it & 3; }
  const int Tseq = lat ? 4096 : 256;
  const bf16_t* PQKV = (const bf16_t*)(p.ws + OFF_PQKV);
  const float* PAB = (const float*)(p.ws + OFF_PAB);

  bf16_t* raw = (bf16_t*)smem;
  float* KK = (float*)smem;
  float* QK = KK + 64 * 68;
  bf16_t* qb = (bf16_t*)(smem + 51456);
  bf16_t* kb = qb + 64 * 136;
  float* vf = (float*)(smem + 51456 + 34816);
  float* Am = vf + 64 * 128;
  float* gcs = Am + 2 * 64 * 64;
  float* bet = gcs + 128;
  float* beg = bet + 128;

#pragma unroll
  for (int i = 0; i < 7; ++i) {
    const int s = tid + i * NT;
    if (s < 67 * 48) {
      const int rr = s / 48, q = s % 48;
      *(u32x4*)(raw + rr * 384 + (q >> 4) * 128 + (q & 15) * 8) = pr[i];
    }
  }
  for (int s = tid; s < 4 * 384; s += NT) {
    const int kk = s / 384, q = s % 384;
    Am[s] = p.gdn_conv_w[kk * 1536 + (q >> 7) * 512 + h * 128 + (q & 127)];
  }
  if (tid < 128) {
    const int dir = tid >> 6, i = tid & 63;
    const int tok = dir ? 63 - i : i;
    const int j = c * 64 + tok;
    const size_t grow = lat ? (size_t)b * 4096 + (size_t)((j & 63) * 64 + (j >> 6)) : (size_t)RLAT + b * 256 + j;
    const float a_ = PAB[grow * 16 + dir * 8 + h];
    const float b_ = PAB[grow * 16 + dir * 8 + 4 + h];
    float g = -__expf(p.gdn_a_log[dir * 4 + h]) * softplusf_(a_ + p.gdn_dt_bias[dir * 4 + h]);
    const float be = sigmoidf_(b_);
#pragma unroll
    for (int o = 1; o < 64; o <<= 1) {
      float t = __shfl_up(g, o, 64);
      if (lane >= o) g += t;
    }
    gcs[dir * 64 + i] = g;
    bet[dir * 64 + i] = be;
    beg[dir * 64 + i] = be * __expf(g);
  }
  __syncthreads();
  {
    float* cwL = Am;
    const int i = tid >> 3, sg = tid & 7;
#pragma unroll
    for (int part = 0; part < 3; ++part) {
      float y[16];
#pragma unroll
      for (int d = 0; d < 16; ++d) y[d] = 0.f;
#pragma unroll
      for (int kk = 0; kk < 4; ++kk) {
        const u32x4 r0 = *(const u32x4*)(raw + (i + kk) * 384 + part * 128 + sg * 16);
        const u32x4 r1 = *(const u32x4*)(raw + (i + kk) * 384 + part * 128 + sg * 16 + 8);
        const float* cwp = cwL + kk * 384 + part * 128 + sg * 16;
#pragma unroll
        for (int m = 0; m < 4; ++m) {
          const f32x4 w4 = *(const f32x4*)(cwp + 4 * m);
          const unsigned lo = (m < 2) ? r0[2 * m] : r1[2 * m - 4];
          const unsigned hi = (m < 2) ? r0[2 * m + 1] : r1[2 * m - 3];
          y[4 * m + 0] += w4[0] * __uint_as_float(lo << 16);
          y[4 * m + 1] += w4[1] * __uint_as_float(lo & 0xffff0000u);
          y[4 * m + 2] += w4[2] * __uint_as_float(hi << 16);
          y[4 * m + 3] += w4[3] * __uint_as_float(hi & 0xffff0000u);
        }
      }
      float ss = 0.f;
#pragma unroll
      for (int d = 0; d < 16; ++d) { y[d] = siluf_(y[d]); ss += y[d] * y[d]; }
      if (part < 2) {
        ss += __shfl_xor(ss, 1, 64);
        ss += __shfl_xor(ss, 2, 64);
        ss += __shfl_xor(ss, 4, 64);
        float scl = rsqrtf(ss + 1e-6f);
        if (part == 0) scl *= 0.08838834764831845f;
        bf16_t* dst = (part == 0 ? qb : kb) + i * 136 + sg * 16;
#pragma unroll
        for (int d = 0; d < 16; d += 2) *(unsigned*)(dst + d) = pack2(y[d] * scl, y[d + 1] * scl);
      } else {
#pragma unroll
        for (int d = 0; d < 16; ++d) vf[i * 128 + sg * 16 + d] = y[d];
      }
    }
  }
  __syncthreads();
  {
    const int which = w >> 2, tm = (w >> 1) & 1, tn = w & 1;
    const int r = lane & 31, hh = lane >> 5;
    const bf16_t* Ap = which ? qb : kb;
    f32x16 acc;
#pragma unroll
    for (int q = 0; q < 16; ++q) acc[q] = 0.f;
#pragma unroll
    for (int ks = 0; ks < 8; ++ks) {
      bf16x8 a = *(const bf16x8*)(Ap + (tm * 32 + r) * 136 + ks * 16 + hh * 8);
      bf16x8 bb = *(const bf16x8*)(kb + (tn * 32 + r) * 136 + ks * 16 + hh * 8);
      acc = MFMA32(a, bb, acc);
    }
    float* dst = which ? QK : KK;
#pragma unroll
    for (int q = 0; q < 16; ++q) {
      const int row = tm * 32 + (q & 3) + 8 * (q >> 2) + 4 * hh;
      dst[row * 68 + tn * 32 + r] = acc[q];
    }
  }
  __syncthreads();
  const int cidF = chunk_id(0, b, h, lat ? 4 + c : c);
  const int cidB = chunk_id(1, b, h, lat ? 4 + (63 - c) : 3 - c);
  {
    bf16_t* AT = (bf16_t*)((unsigned char*)p.out + OUT_AT);
    bf16_t* QG = (bf16_t*)(p.ws + OFF_QG);
    bf16_t* KDT = (bf16_t*)(p.ws + OFF_KDT);
    float* EGL = (float*)(p.ws + OFF_EGL);
    for (int e = tid; e < 2 * 64 * 64; e += NT) {
      const int dir = e >> 12, i = (e >> 6) & 63, s = e & 63;
      const int ti = dir ? 63 - i : i, ts = dir ? 63 - s : s;
      Am[e] = (i > s) ? bet[dir * 64 + i] * KK[ti * 68 + ts] * __expf(gcs[dir * 64 + i] - gcs[dir * 64 + s]) : 0.f;
    }
#pragma unroll 1
    for (int t = 0; t < 2; ++t) {
      const int e = tid + t * NT;
      const int dir = e >> 9, i = (e >> 3) & 63, s8 = e & 7;
      const int ti = dir ? 63 - i : i;
      const float gi = gcs[dir * 64 + i];
      float v[8];
#pragma unroll
      for (int k = 0; k < 8; ++k) {
        const int s = s8 * 8 + k;
        const int ts = dir ? 63 - s : s;
        v[k] = (i >= s) ? QK[ti * 68 + ts] * __expf(gi - gcs[dir * 64 + s]) : 0.f;
      }
      u32x4 o;
#pragma unroll
      for (int k = 0; k < 4; ++k) o[k] = pack2(v[2 * k], v[2 * k + 1]);
      *(u32x4*)(AT + (size_t)(dir ? cidB : cidF) * 4096 + i * 64 + s8 * 8) = o;
    }
#pragma unroll 1
    for (int t = 0; t < 4; ++t) {
      const int e = tid + t * NT;
      const int dir = e >> 10, i = (e >> 4) & 63, d8 = e & 15;
      const int ti = dir ? 63 - i : i;
      const float eg = __expf(gcs[dir * 64 + i]);
      const u32x4 qv = *(const u32x4*)(qb + ti * 136 + d8 * 8);
      u32x4 o;
#pragma unroll
      for (int k = 0; k < 4; ++k) o[k] = pack2(__uint_as_float(qv[k] << 16) * eg, __uint_as_float(qv[k] & 0xffff0000u) * eg);
      *(u32x4*)(QG + (size_t)(dir ? cidB : cidF) * 8192 + i * 128 + d8 * 8) = o;
    }
#pragma unroll 1
    for (int t = 0; t < 4; ++t) {
      const int e = tid + t * NT;
      const int dir = e >> 10, i8 = (e >> 7) & 7, d = e & 127;
      const float gl = gcs[dir * 64 + 63];
      float v[8];
#pragma unroll
      for (int k = 0; k < 8; ++k) {
        const int i = i8 * 8 + k;
        const int ti = dir ? 63 - i : i;
        v[k] = bf2f(kb[ti * 136 + d]) * __expf(gl - gcs[dir * 64 + i]);
      }
      u32x4 o;
#pragma unroll
      for (int k = 0; k < 4; ++k) o[k] = pack2(v[2 * k], v[2 * k + 1]);
      *(u32x4*)(KDT + (size_t)(dir ? cidB : cidF) * 8192 + d * 64 + i8 * 8) = o;
    }
    if (tid < 2) EGL[tid ? cidB : cidF] = __expf(gcs[tid * 64 + 63]);
  }
  __syncthreads();
  if (next_item < 2176) prepass_preload(p, next_item, pr, pf);
  {
    const int dir = tid >> 8, cidx = tid & 255;
    lds_b* sdst = (lds_b*)((bf16_t*)smem + (dir * 64) * 256 + cidx);
    if (dir == 0) {
      if (cidx < 128) solve_col<0, 0>((lds_cf*)Am, (lds_cf*)(vf + cidx), (lds_cb*)kb, (lds_cf*)bet, sdst);
      else solve_col<0, 1>((lds_cf*)Am, (lds_cf*)vf, (lds_cb*)(kb + (cidx - 128)), (lds_cf*)beg, sdst);
    } else {
      if (cidx < 128) solve_col<1, 0>((lds_cf*)(Am + 4096), (lds_cf*)(vf + cidx), (lds_cb*)kb, (lds_cf*)(bet + 64), sdst);
      else solve_col<1, 1>((lds_cf*)(Am + 4096), (lds_cf*)vf, (lds_cb*)(kb + (cidx - 128)), (lds_cf*)(beg + 64), sdst);
    }
  }
  __syncthreads();
  {
    bf16_t* WVg = (bf16_t*)((unsigned char*)p.out + OUT_WV);
    bf16_t* KCg = (bf16_t*)(p.ws + OFF_KC);
    const bf16_t* solL = (const bf16_t*)smem;
#pragma unroll 1
    for (int t = 0; t < 8; ++t) {
      const int e = tid + t * NT;
      const int dir = e >> 11, i = (e >> 5) & 63, sg = e & 31;
      const u32x4 v = *(const u32x4*)(solL + (dir * 64 + i) * 256 + sg * 8);
      bf16_t* dstp = (sg < 16) ? WVg + (size_t)(dir ? cidB : cidF) * 8192 + i * 128 + sg * 8
                               : KCg + (size_t)(dir ? cidB : cidF) * 8192 + i * 128 + (sg - 16) * 8;
      *(u32x4*)dstp = v;
    }
  }
  __syncthreads();
}

__device__ void gdn_seq_item(const Params& p, int item, unsigned char* smem) {
  const int tid = threadIdx.x, lane = tid & 63, w = tid >> 6;
  const int dvh = item & 1, h = (item >> 1) & 3, b = (item >> 3) & 7, dir = item >> 6;
  const bf16_t* KC = (const bf16_t*)(p.ws + OFF_KC);
  const bf16_t* QG = (const bf16_t*)(p.ws + OFF_QG);
  const bf16_t* KDT = (const bf16_t*)(p.ws + OFF_KDT);
  const bf16_t* WV = (const bf16_t*)((unsigned char*)p.out + OUT_WV);
  const bf16_t* AT = (const bf16_t*)((unsigned char*)p.out + OUT_AT);
  const float* EGL = (const float*)(p.ws + OFF_EGL);
  bf16_t* Odir = (bf16_t*)(p.ws + OFF_PQKV) + (size_t)dir * RLAT * 512;

  bf16_t* KCs = (bf16_t*)smem;
  bf16_t* QGs = KCs + 64 * 136;
  bf16_t* St = QGs + 64 * 136;
  bf16_t* ATs = St + 64 * 136;
  bf16_t* VnT = ATs + 64 * 72;
  bf16_t* WVs = VnT + 64 * 72;
  bf16_t* KDTs = WVs + 64 * 72;

  const int dkt = w >> 1, dvt = w & 1;
  const int r32 = lane & 31, h32 = lane >> 5;
  const int l15 = lane & 15, q4 = lane >> 4;
  const int tm = w >> 1, tn0 = (w & 1) * 2;
  f32x16 S;
#pragma unroll
  for (int q = 0; q < 16; ++q) S[q] = 0.f;
  for (int i = tid; i < 64 * 136 / 2; i += NT) ((unsigned*)St)[i] = 0u;

  const int cid0 = chunk_id(dir, b, h, 0);
  u32x4 rA[8], rB[8];
  float eglA, eglB;
#define SEQ_LOAD(R, EG, cid_)                                                                 \
  {                                                                                           \
    const size_t base_ = (size_t)(cid_) * 8192;                                               \
    R[0] = *(const u32x4*)(KC + base_ + tid * 8);                                             \
    R[1] = *(const u32x4*)(KC + base_ + (tid + 512) * 8);                                     \
    R[2] = *(const u32x4*)(QG + base_ + tid * 8);                                             \
    R[3] = *(const u32x4*)(QG + base_ + (tid + 512) * 8);                                     \
    R[4] = *(const u32x4*)(KDT + base_ + tid * 8);                                            \
    R[5] = *(const u32x4*)(KDT + base_ + (tid + 512) * 8);                                    \
    R[6] = *(const u32x4*)(AT + (size_t)(cid_) * 4096 + tid * 8);                             \
    R[7] = *(const u32x4*)(WV + base_ + (tid >> 3) * 128 + dvh * 64 + (tid & 7) * 8);        \
    EG = EGL[cid_];                                                                           \
  }
#define SEQ_STORE(R)                                                       \
  {                                                                        \
    *(u32x4*)(KCs + (tid >> 4) * 136 + (tid & 15) * 8) = R[0];             \
    *(u32x4*)(KCs + ((tid + 512) >> 4) * 136 + (tid & 15) * 8) = R[1];     \
    *(u32x4*)(QGs + (tid >> 4) * 136 + (tid & 15) * 8) = R[2];             \
    *(u32x4*)(QGs + ((tid + 512) >> 4) * 136 + (tid & 15) * 8) = R[3];     \
    *(u32x4*)(KDTs + (tid >> 3) * 72 + (tid & 7) * 8) = R[4];              \
    *(u32x4*)(KDTs + ((tid + 512) >> 3) * 72 + (tid & 7) * 8) = R[5];      \
    *(u32x4*)(ATs + (tid >> 3) * 72 + (tid & 7) * 8) = R[6];               \
    *(u32x4*)(WVs + (tid >> 3) * 72 + (tid & 7) * 8) = R[7];               \
  }
  auto compute = [&](const int ci, const float egl) __attribute__((always_inline)) {
    f32x4 accO[2];
#pragma unroll
    for (int t = 0; t < 2; ++t) {
      const int tn = tn0 + t;
      f32x4 accV = {0.f, 0.f, 0.f, 0.f};
      accO[t] = accV;
#pragma unroll
      for (int ks = 0; ks < 4; ++ks) {
        bf16x8 aK = *(const bf16x8*)(KCs + (tm * 16 + l15) * 136 + ks * 32 + q4 * 8);
        bf16x8 aQ = *(const bf16x8*)(QGs + (tm * 16 + l15) * 136 + ks * 32 + q4 * 8);
        bf16x8 bS = *(const bf16x8*)(St + (tn * 16 + l15) * 136 + ks * 32 + q4 * 8);
        accV = MFMA16(aK, bS, accV);
        accO[t] = MFMA16(aQ, bS, accO[t]);
      }
      float vn[4];
#pragma unroll
      for (int q = 0; q < 4; ++q) vn[q] = bf2f(WVs[(tm * 16 + q4 * 4 + q) * 72 + tn * 16 + l15]) - accV[q];
      uint2 pk;
      pk.x = pack2(vn[0], vn[1]);
      pk.y = pack2(vn[2], vn[3]);
      *(uint2*)(VnT + (tn * 16 + l15) * 72 + tm * 16 + q4 * 4) = pk;
    }
    __syncthreads();
#pragma unroll
    for (int t = 0; t < 2; ++t) {
      const int tn = tn0 + t;
#pragma unroll
      for (int ks = 0; ks < 2; ++ks) {
        bf16x8 aA = *(const bf16x8*)(ATs + (tm * 16 + l15) * 72 + ks * 32 + q4 * 8);
        bf16x8 bV = *(const bf16x8*)(VnT + (tn * 16 + l15) * 72 + ks * 32 + q4 * 8);
        accO[t] = MFMA16(aA, bV, accO[t]);
      }
      if (ci >= 4) {
#pragma unroll
        for (int q = 0; q < 4; ++q) {
          const int i = tm * 16 + q4 * 4 + q;
          const int sp = (ci - 4) * 64 + i;
          const int j = dir ? 4095 - sp : sp;
          const int t_r = (j & 63) * 64 + (j >> 6);
          Odir[((size_t)b * 4096 + t_r) * 512 + h * 128 + dvh * 64 + tn * 16 + l15] = f2bf(accO[t][q]);
        }
      }
    }
#pragma unroll
    for (int q = 0; q < 16; ++q) S[q] *= egl;
#pragma unroll
    for (int ks = 0; ks < 4; ++ks) {
      bf16x8 a = *(const bf16x8*)(KDTs + (dkt * 32 + r32) * 72 + ks * 16 + h32 * 8);
      bf16x8 bb = *(const bf16x8*)(VnT + (dvt * 32 + r32) * 72 + ks * 16 + h32 * 8);
      S = MFMA32(a, bb, S);
    }
#pragma unroll
    for (int g = 0; g < 4; ++g) {
      uint2 pk;
      pk.x = pack2(S[4 * g + 0], S[4 * g + 1]);
      pk.y = pack2(S[4 * g + 2], S[4 * g + 3]);
      *(uint2*)(St + (dvt * 32 + r32) * 136 + dkt * 32 + 8 * g + 4 * h32) = pk;
    }
    __syncthreads();
  };
  SEQ_LOAD(rA, eglA, cid0)
  SEQ_LOAD(rB, eglB, cid0 + 1)
  for (int ci = 0; ci < 68; ci += 2) {
    SEQ_STORE(rA)
    const float e0 = eglA;
    __syncthreads();
    if (ci + 2 < 68) SEQ_LOAD(rA, eglA, cid0 + ci + 2)
    compute(ci, e0);
    SEQ_STORE(rB)
    const float e1 = eglB;
    __syncthreads();
    if (ci + 3 < 68) SEQ_LOAD(rB, eglB, cid0 + ci + 3)
    compute(ci + 1, e1);
  }
#undef SEQ_LOAD
#undef SEQ_STORE
}

__device__ __forceinline__ float neg_expm1(float y) {
  return (y > -0.02f) ? -(y + 0.5f * y * y + (1.f / 6.f) * y * y * y) : 1.f - __expf(y);
}
__device__ void rglru_item(const Params& p, int it, unsigned char* smem) {
  const int tid = threadIdx.x, lane = tid & 63, w = tid >> 6;
  const int n = it & 7, b = (it >> 3) & 7, dir = it >> 6;
  const bf16_t* PRG = (const bf16_t*)(p.ws + OFF_PRG);
  bf16_t* Hdir = (bf16_t*)(p.ws + OFF_H) + (size_t)dir * RLAT * 512;
  bf16_t* ur = (bf16_t*)smem;
  bf16_t* xcb = ur + 132 * 72;
  bf16_t* wgt = xcb + 128 * 72;
  float* aL = (float*)(smem + (132 + 128 + 128) * 72 * 2);
  float* bL = aL + 128 * 64;
  float* segA = bL + 128 * 64;
  float* segB = segA + 512;
  for (int i = tid; i < 2 * 64 * 64; i += NT) {
    const int g = i >> 12, d = (i >> 6) & 63, e = i & 63;
    wgt[(g * 64 + e) * 72 + d] = f2bf(p.rg_gate_w[((((size_t)dir * 2 + g) * 8 + n) * 64 + d) * 64 + e]);
  }
  float* cwL = segB + 512;
  if (tid < 320) {
    const int kk = tid >> 6, e = tid & 63;
    cwL[tid] = (kk < 4) ? p.rg_conv_w[kk * 512 + n * 64 + e] : p.rg_conv_b[n * 64 + e];
  }
  const int cseg = tid & 7;
  const int tt = w >> 1, et = w & 1, r32 = lane & 31, h32 = lane >> 5;
  const int eg = et * 32 + r32;
  const float bias_r = p.rg_gate_b[(dir * 2 + 0) * 512 + n * 64 + eg];
  const float bias_i = p.rg_gate_b[(dir * 2 + 1) * 512 + n * 64 + eg];
  const float sp8 = -8.f * softplusf_(-p.rg_lambda[dir * 512 + n * 64 + eg]);
  float hstate = 0.f;
  u32x4 pu0, pu1, pu2;
#define RG_LOAD(tile_)                                                                           \
  {                                                                                              \
    const bool lat_ = (tile_) >= 2;                                                              \
    const int tl_ = lat_ ? (tile_) - 2 : (tile_);                                                \
    const int ntl_ = lat_ ? 32 : 2;                                                              \
    const int t0_ = (dir ? (ntl_ - 1 - tl_) : tl_) * 128;                                        \
    const int Tseq_ = lat_ ? 4096 : 256;                                                         \
    const size_t rbase_ = lat_ ? (size_t)b * 4096 : (size_t)RLAT + b * 256;                      \
    const u32x4 z_ = {0u, 0u, 0u, 0u};                                                           \
    { const int s_ = tid; const int t_ = t0_ - 2 + (s_ >> 3);                                   \
      pu0 = (t_ >= 0 && t_ < Tseq_) ? *(const u32x4*)(PRG + (rbase_ + t_) * 1024 + n * 64 + (s_ & 7) * 8) : z_; } \
    { const int s_ = tid + 512; const int t_ = t0_ - 2 + (s_ >> 3);                             \
      pu1 = (t_ >= 0 && t_ < Tseq_) ? *(const u32x4*)(PRG + (rbase_ + t_) * 1024 + n * 64 + (s_ & 7) * 8) : z_; } \
    { const int s_ = tid + 1024; const int t_ = t0_ - 2 + (s_ >> 3);                            \
      pu2 = (s_ < 1048 && t_ >= 0 && t_ < Tseq_) ? *(const u32x4*)(PRG + (rbase_ + t_) * 1024 + n * 64 + (s_ & 7) * 8) : z_; } \
  }
  RG_LOAD(0)
  for (int tile = 0; tile < 34; ++tile) {
    const bool lat = tile >= 2;
    const int tl = lat ? tile - 2 : tile;
    const int ntl = lat ? 32 : 2;
    const int t0 = (dir ? (ntl - 1 - tl) : tl) * 128;
    *(u32x4*)(ur + (tid >> 3) * 72 + (tid & 7) * 8) = pu0;
    *(u32x4*)(ur + ((tid + 512) >> 3) * 72 + (tid & 7) * 8) = pu1;
    if (tid + 1024 < 1048) *(u32x4*)(ur + ((tid + 1024) >> 3) * 72 + (tid & 7) * 8) = pu2;
    __syncthreads();
    if (tile + 1 < 34) RG_LOAD(tile + 1)
#pragma unroll
    for (int half = 0; half < 2; ++half) {
      const int tok = (tid >> 3) + half * 64;
      float a[8];
      {
        const f32x4 c0 = *(const f32x4*)(cwL + 256 + cseg * 8), c1 = *(const f32x4*)(cwL + 256 + cseg * 8 + 4);
#pragma unroll
        for (int j = 0; j < 4; ++j) { a[j] = c0[j]; a[4 + j] = c1[j]; }
      }
#pragma unroll
      for (int kk = 0; kk < 4; ++kk) {
        const u32x4 uv = *(const u32x4*)(ur + (tok + kk) * 72 + cseg * 8);
        const f32x4 w0 = *(const f32x4*)(cwL + kk * 64 + cseg * 8), w1 = *(const f32x4*)(cwL + kk * 64 + cseg * 8 + 4);
        a[0] += w0[0] * __uint_as_float(uv[0] << 16);
        a[1] += w0[1] * __uint_as_float(uv[0] & 0xffff0000u);
        a[2] += w0[2] * __uint_as_float(uv[1] << 16);
        a[3] += w0[3] * __uint_as_float(uv[1] & 0xffff0000u);
        a[4] += w1[0] * __uint_as_float(uv[2] << 16);
        a[5] += w1[1] * __uint_as_float(uv[2] & 0xffff0000u);
        a[6] += w1[2] * __uint_as_float(uv[3] << 16);
        a[7] += w1[3] * __uint_as_float(uv[3] & 0xffff0000u);
      }
      u32x4 o;
#pragma unroll
      for (int m = 0; m < 4; ++m) o[m] = pack2(a[2 * m], a[2 * m + 1]);
      *(u32x4*)(xcb + tok * 72 + cseg * 8) = o;
    }
    __syncthreads();
    {
      f32x16 accR, accI;
#pragma unroll
      for (int q = 0; q < 16; ++q) { accR[q] = 0.f; accI[q] = 0.f; }
#pragma unroll
      for (int ks = 0; ks < 4; ++ks) {
        bf16x8 a = *(const bf16x8*)(xcb + (tt * 32 + r32) * 72 + ks * 16 + h32 * 8);
        bf16x8 br = *(const bf16x8*)(wgt + (et * 32 + r32) * 72 + ks * 16 + h32 * 8);
        bf16x8 bi = *(const bf16x8*)(wgt + (64 + et * 32 + r32) * 72 + ks * 16 + h32 * 8);
        accR = MFMA32(a, br, accR);
        accI = MFMA32(a, bi, accI);
      }
#pragma unroll
      for (int q = 0; q < 16; ++q) {
        const int tok = tt * 32 + (q & 3) + 8 * (q >> 2) + 4 * h32;
        const float er = __expf(-(accR[q] + bias_r)), ei = __expf(-(accI[q] + bias_i));
        const float dr = 1.f + er, di = 1.f + ei;
        const float inv = __frcp_rn(dr * di);
        const float rr = inv * di, ii = inv * dr;
        const float log_a = sp8 * rr;
        const float av = __expf(log_a);
        const float y = -2.f * log_a;
        const float om = (y < 0.04f) ? y * (1.f - y * (0.5f - y * (1.f / 6.f - y * (1.f / 24.f)))) : 1.f - av * av;
        const float xv = bf2f(xcb[tok * 72 + eg]);
        aL[tok * 64 + eg] = av;
        bL[tok * 64 + eg] = __builtin_amdgcn_sqrtf(om) * (ii * xv);
      }
    }
    __syncthreads();
    float Pk[16], Hk[16];
    {
      float P = 1.f, hl = 0.f;
#pragma unroll
      for (int k = 0; k < 16; ++k) {
        const int s = 16 * w + k;
        const int tok = dir ? 127 - s : s;
        const float av = aL[tok * 64 + lane], bv = bL[tok * 64 + lane];
        hl = av * hl + bv;
        P = P * av;
        Pk[k] = P;
        Hk[k] = hl;
      }
      segA[w * 64 + lane] = P;
      segB[w * 64 + lane] = hl;
    }
    __syncthreads();
    {
      float hin = hstate, my_in = 0.f;
#pragma unroll
      for (int ww = 0; ww < 8; ++ww) {
        if (ww == w) my_in = hin;
        hin = segA[ww * 64 + lane] * hin + segB[ww * 64 + lane];
      }
      hstate = hin;
      if (lat) {
#pragma unroll
        for (int k = 0; k < 16; ++k) {
          const int s = 16 * w + k;
          const int tok = dir ? 127 - s : s;
          Hdir[((size_t)b * 4096 + t0 + tok) * 512 + n * 64 + lane] = f2bf(Pk[k] * my_in + Hk[k]);
        }
      }
    }
  }
  __syncthreads();
#undef RG_LOAD
}

__device__ void phase_ya(const Params& p) {
  const int lane = threadIdx.x & 63, w = threadIdx.x >> 6;
  const bf16_t* PRG = (const bf16_t*)(p.ws + OFF_PRG);
  const bf16_t* PZ = (const bf16_t*)(p.ws + OFF_PZ);
  const bf16_t* HF = (const bf16_t*)(p.ws + OFF_H);
  const bf16_t* HB = HF + (size_t)RLAT * 512;
  const bf16_t* OF = (const bf16_t*)(p.ws + OFF_PQKV);
  const bf16_t* OB = OF + (size_t)RLAT * 512;
  bf16_t* YA = (bf16_t*)(p.ws + OFF_QG);
  for (int row = blockIdx.x * 8 + w; row < RLAT; row += gridDim.x * 8) {
    const int c0 = lane * 8;
    uint4 hf = *(const uint4*)(HF + (size_t)row * 512 + c0);
    uint4 hb = *(const uint4*)(HB + (size_t)row * 512 + c0);
    uint4 gt = *(const uint4*)(PRG + (size_t)row * 1024 + 512 + c0);
    uint4 of = *(const uint4*)(OF + (size_t)row * 512 + c0);
    uint4 ob = *(const uint4*)(OB + (size_t)row * 512 + c0);
    uint4 zz = *(const uint4*)(PZ + (size_t)row * 512 + c0);
    const unsigned* hfp = (const unsigned*)&hf; const unsigned* hbp = (const unsigned*)&hb;
    const unsigned* gtp = (const unsigned*)&gt; const unsigned* ofp = (const unsigned*)&of;
    const unsigned* obp = (const unsigned*)&ob; const unsigned* zzp = (const unsigned*)&zz;
    float y[8], o[8], z[8];
    float ss = 0.f;
#pragma unroll
    for (int q = 0; q < 4; ++q) {
      float hf0 = bf2f((bf16_t)(hfp[q] & 0xffff)), hf1 = bf2f((bf16_t)(hfp[q] >> 16));
      float hb0 = bf2f((bf16_t)(hbp[q] & 0xffff)), hb1 = bf2f((bf16_t)(hbp[q] >> 16));
      float g0 = bf2f((bf16_t)(gtp[q] & 0xffff)), g1 = bf2f((bf16_t)(gtp[q] >> 16));
      y[2 * q] = (hf0 + hb0) * gelu_tanh(g0);
      y[2 * q + 1] = (hf1 + hb1) * gelu_tanh(g1);
      o[2 * q] = bf2f((bf16_t)(ofp[q] & 0xffff)) + bf2f((bf16_t)(obp[q] & 0xffff));
      o[2 * q + 1] = bf2f((bf16_t)(ofp[q] >> 16)) + bf2f((bf16_t)(obp[q] >> 16));
      z[2 * q] = bf2f((bf16_t)(zzp[q] & 0xffff));
      z[2 * q + 1] = bf2f((bf16_t)(zzp[q] >> 16));
      ss += o[2 * q] * o[2 * q] + o[2 * q + 1] * o[2 * q + 1];
    }
    ss += __shfl_xor(ss, 1, 64);
    ss += __shfl_xor(ss, 2, 64);
    ss += __shfl_xor(ss, 4, 64);
    ss += __shfl_xor(ss, 8, 64);
    const float rstd = rsqrtf(ss * (1.f / 128.f) + 1e-6f);
    const int d0 = (lane & 15) * 8;
    uint4 o1, o2;
    unsigned* o1p = (unsigned*)&o1; unsigned* o2p = (unsigned*)&o2;
#pragma unroll
    for (int q = 0; q < 4; ++q) {
      o1p[q] = pack2(y[2 * q], y[2 * q + 1]);
      float a0 = o[2 * q] * rstd * p.gdn_norm_g[d0 + 2 * q] * siluf_(z[2 * q]);
      float a1 = o[2 * q + 1] * rstd * p.gdn_norm_g[d0 + 2 * q + 1] * siluf_(z[2 * q + 1]);
      o2p[q] = pack2(a0, a1);
    }
    *(uint4*)(YA + (size_t)row * 1024 + c0) = o1;
    *(uint4*)(YA + (size_t)row * 1024 + 512 + c0) = o2;
  }
}

__device__ void phase_outproj(const Params& p, unsigned char* smem) {
  const bf16_t* YA = (const bf16_t*)(p.ws + OFF_QG);
  const bf16_t* WT = (const bf16_t*)(p.ws + OFF_WOUT);
  const float* mod = (const float*)(p.ws + OFF_MOD);
  const int lane = threadIdx.x & 63, w = threadIdx.x >> 6;
  const int wm = w >> 2, wn = w & 3, r = lane & 31, h = lane >> 5;
  const bool swz = (gridDim.x == 256);
  const int xcd = blockIdx.x & 7;
  const int ntiles = swz ? 16 * 4 : 128 * 4;
  for (int k = swz ? (blockIdx.x >> 3) : blockIdx.x; k < ntiles; k += swz ? 32 : gridDim.x) {
    const int mt = swz ? xcd + 8 * (k >> 2) : (k >> 2), nt = k & 3;
    const int m0 = mt * 256, n0 = nt * 256;
    f32x16 acc[4][2];
    gemm_tile256(YA + (size_t)m0 * 1024, WT + (size_t)n0 * 1024, acc, smem);
    const int bb = m0 >> 12;
    float* Cf = (float*)(smem + w * 8704);
#pragma unroll
    for (int i = 0; i < 4; ++i) {
#pragma unroll
      for (int j = 0; j < 2; ++j)
#pragma unroll
        for (int q = 0; q < 16; ++q) Cf[((q & 3) + 8 * (q >> 2) + 4 * h) * 68 + j * 32 + r] = acc[i][j][q];
#pragma unroll
      for (int it = 0; it < 8; ++it) {
        const int row = (lane >> 4) + 4 * it, seg = lane & 15;
        const f32x4 av = *(const f32x4*)(Cf + row * 68 + seg * 4);
        const size_t grow = m0 + wm * 128 + i * 32 + row;
        const int n = n0 + wn * 64 + seg * 4;
        const f32x4 xv = *(const f32x4*)(p.x + grow * 1024 + n);
        const f32x4 gv = *(const f32x4*)(mod + bb * 6144 + 2048 + n);
        f32x4 o;
        o[0] = xv[0] + gv[0] * av[0]; o[1] = xv[1] + gv[1] * av[1]; o[2] = xv[2] + gv[2] * av[2]; o[3] = xv[3] + gv[3] * av[3];
        *(f32x4*)(p.out + grow * 1024 + n) = o;
      }
    }
  }
}

#define INS16(list, val)                       \
  {                                            \
    float nv_ = (val);                         \
    _Pragma("unroll") for (int k_ = 0; k_ < 16; ++k_) { \
      float hi_ = fmaxf(list[k_], nv_);        \
      nv_ = fminf(list[k_], nv_);              \
      list[k_] = hi_;                          \
    }                                          \
  }

__device__ __forceinline__ void cswap_desc(float& a, float& b) {
  const float hi = fmaxf(a, b), lo = fminf(a, b);
  a = hi;
  b = lo;
}
__device__ __forceinline__ void bitonic_sort16_desc(float (&a)[16]) {
#pragma unroll
  for (int k = 2; k <= 16; k <<= 1)
#pragma unroll
    for (int j = k >> 1; j > 0; j >>= 1)
#pragma unroll
      for (int i = 0; i < 16; ++i) {
        const int l = i ^ j;
        if (l > i) {
          if ((i & k) == 0) cswap_desc(a[i], a[l]);
          else cswap_desc(a[l], a[i]);
        }
      }
}
__device__ __forceinline__ void merge_top16_desc(float (&a)[16], const float (&b)[16]) {
#pragma unroll
  for (int i = 0; i < 16; ++i) a[i] = fmaxf(a[i], b[15 - i]);
#pragma unroll
  for (int j = 8; j > 0; j >>= 1)
#pragma unroll
    for (int i = 0; i < 16; ++i) {
      const int l = i ^ j;
      if (l > i) cswap_desc(a[i], a[l]);
    }
}

__device__ void phase_peer_query(const Params& p, unsigned char* smem) {
  const bf16_t* H2 = (const bf16_t*)(p.ws + OFF_PRG);
  const bf16_t* WT = (const bf16_t*)(p.ws + OFF_WQ);
  const bf16_t* KEYS = (const bf16_t*)(p.ws + OFF_KEYS);
  float* LISTS = (float*)(p.ws + OFF_PZ);
  bf16_t* Qs = (bf16_t*)smem;
  bf16_t* Ks = (bf16_t*)(smem + 69632);
  const int tid = threadIdx.x, lane = tid & 63, w = tid >> 6;
  const int wm = w >> 1, wn = w & 1, r = lane & 31, h = lane >> 5;
  const bool swz = (gridDim.x == 256);
  const int xcd = blockIdx.x & 7;
  const int ntiles = swz ? 16 * 16 : 128 * 16;
  for (int k = swz ? (blockIdx.x >> 3) : blockIdx.x; k < ntiles; k += swz ? 32 : gridDim.x) {
    int mt, hx;
    if (!swz) { mt = k >> 4; hx = k & 15; }
    else { const int g = k >> 7, kk = k & 127; mt = xcd + 8 * (kk >> 3); hx = g * 8 + (kk & 7); }
    const int m0 = mt * 256, n0 = hx * 128;
    const int xh = hx & 1;
    f32x16 acc[2][2];
    gemm_tile(H2 + (size_t)m0 * 1024, WT + (size_t)n0 * 1024, acc, smem);
#pragma unroll
    for (int i = 0; i < 2; ++i)
#pragma unroll
      for (int j = 0; j < 2; ++j)
#pragma unroll
        for (int q = 0; q < 16; ++q) {
          const int row = wm * 64 + i * 32 + (q & 3) + 8 * (q >> 2) + 4 * h;
          const int col = wn * 64 + j * 32 + r;
          Qs[row * 136 + col] = f2bf(acc[i][j][q]);
        }
#pragma unroll
    for (int i = 0; i < 4; ++i) {
      int seg = tid + 512 * i;
      *(uint4*)(Ks + (seg >> 4) * 136 + (seg & 15) * 8) = *(const uint4*)(KEYS + (size_t)xh * 16384 + seg * 8);
    }
    __syncthreads();
    f32x16 sc[4];
#pragma unroll
    for (int m4 = 0; m4 < 4; ++m4)
#pragma unroll
      for (int q = 0; q < 16; ++q) sc[m4][q] = 0.f;
#pragma unroll
    for (int ks = 0; ks < 8; ++ks) {
      bf16x8 bq = *(const bf16x8*)(Qs + (w * 32 + r) * 136 + ks * 16 + h * 8);
#pragma unroll
      for (int m4 = 0; m4 < 4; ++m4) {
        bf16x8 ak = *(const bf16x8*)(Ks + (m4 * 32 + r) * 136 + ks * 16 + h * 8);
        sc[m4] = MFMA32(ak, bq, sc[m4]);
      }
    }
    float list[16];
#pragma unroll
    for (int m4 = 0; m4 < 4; ++m4) {
      float t[16];
#pragma unroll
      for (int q = 0; q < 16; ++q) {
        const unsigned kidx = (unsigned)(m4 * 32 + (q & 3) + 8 * (q >> 2)) | ((unsigned)h << 2);
        t[q] = __uint_as_float((__float_as_uint(sc[m4][q]) & ~127u) | kidx);
      }
      bitonic_sort16_desc(t);
      if (m4 == 0) {
#pragma unroll
        for (int q = 0; q < 16; ++q) list[q] = t[q];
      } else {
        merge_top16_desc(list, t);
      }
    }
    {
      float other[16];
#pragma unroll
      for (int k = 0; k < 16; ++k) other[k] = __shfl_xor(list[k], 32, 64);
      merge_top16_desc(list, other);
    }
    if (h == 0) {
      const size_t tok = (size_t)m0 + w * 32 + r;
      float4* dst = (float4*)(LISTS + (tok * 16 + hx) * 16);
#pragma unroll
      for (int k = 0; k < 4; ++k) dst[k] = make_float4(list[4 * k], list[4 * k + 1], list[4 * k + 2], list[4 * k + 3]);
    }
    __syncthreads();
  }
}

constexpr size_t OFF_UQ = OFF_KDT;
constexpr size_t OFF_VQ = OFF_KDT + 16777216;
constexpr size_t OFF_SUV = OFF_KC;
constexpr size_t OFF_PD = OFF_KC + 1048576;
constexpr size_t OFF_SELE = OFF_PQKV;
constexpr size_t OFF_SELG = OFF_PQKV + 16777216;
constexpr size_t OFF_HQ = OFF_PQKV + 33554432;
constexpr size_t OFF_HSC = OFF_PQKV + 67108864;
constexpr size_t OFF_CQ = OFF_PQKV + 68157440;
constexpr size_t OFF_CSC = OFF_PQKV + 72351744;
constexpr size_t OFF_SS = OFF_PQKV + 73400320;
__device__ void phase_quant_uv(const Params& p) {
  const int lane = threadIdx.x & 63, w = threadIdx.x >> 6;
  float* SC = (float*)(p.ws + OFF_SUV);
  for (int row = blockIdx.x * 8 + w; row < 32768; row += gridDim.x * 8) {
    const float* src = (row < 16384 ? p.peer_u : p.peer_v) + (size_t)(row & 16383) * 1024 + lane * 16;
    float4 v[4];
    float am = 0.f;
#pragma unroll
    for (int m = 0; m < 4; ++m) {
      v[m] = ((const float4*)src)[m];
      am = fmaxf(am, fmaxf(fmaxf(fabsf(v[m].x), fabsf(v[m].y)), fmaxf(fabsf(v[m].z), fabsf(v[m].w))));
    }
#pragma unroll
    for (int o = 32; o > 0; o >>= 1) am = fmaxf(am, __shfl_xor(am, o, 64));
    am = fmaxf(am, 1e-30f);
    const float inv = 127.f / am;
    u32x4 pk;
#pragma unroll
    for (int m = 0; m < 4; ++m) {
      const unsigned q0 = (unsigned)((int)rintf(v[m].x * inv)) & 255u;
      const unsigned q1 = (unsigned)((int)rintf(v[m].y * inv)) & 255u;
      const unsigned q2 = (unsigned)((int)rintf(v[m].z * inv)) & 255u;
      const unsigned q3 = (unsigned)((int)rintf(v[m].w * inv)) & 255u;
      pk[m] = q0 | (q1 << 8) | (q2 << 16) | (q3 << 24);
    }
    unsigned char* base = p.ws + (row < 16384 ? OFF_UQ : OFF_VQ);
    *(u32x4*)(base + (size_t)(lane >> 3) * 2097152 + (size_t)(row & 16383) * 128 + (lane & 7) * 16) = pk;
    if (lane == 0) SC[row] = am * (1.f / 127.f);
  }
}

__device__ void phase_peer_select(const Params& p, unsigned char* smem) {
  const int tid = threadIdx.x, lane = tid & 63, w = tid >> 6;
  const float* LISTS = (const float*)(p.ws + OFF_PZ);
  unsigned short* SELE = (unsigned short*)(p.ws + OFF_SELE);
  float* SELG = (float*)(p.ws + OFF_SELG);
  int* tab = (int*)smem + tid * 33;
  for (int base = (blockIdx.x * 8 + w) * 8; base < RLAT; base += gridDim.x * 64) {
    const int tok = base + (lane >> 3), hh = lane & 7;
    float s1[16], s2[16];
    const float4* l1 = (const float4*)(LISTS + ((size_t)tok * 16 + hh * 2) * 16);
#pragma unroll
    for (int k = 0; k < 4; ++k) {
      float4 a = l1[k], c2 = l1[4 + k];
      s1[4 * k] = a.x; s1[4 * k + 1] = a.y; s1[4 * k + 2] = a.z; s1[4 * k + 3] = a.w;
      s2[4 * k] = c2.x; s2[4 * k + 1] = c2.y; s2[4 * k + 2] = c2.z; s2[4 * k + 3] = c2.w;
    }
#pragma unroll
    for (int k = 0; k < 16; ++k) {
      tab[k] = (int)(__float_as_uint(s1[k]) & 127u);
      tab[16 + k] = (int)(__float_as_uint(s2[k]) & 127u);
      s1[k] = __uint_as_float(__float_as_uint(s1[k]) & ~127u);
      s2[k] = __uint_as_float(__float_as_uint(s2[k]) & ~127u);
    }
    float list[16];
#pragma unroll
    for (int k = 0; k < 16; ++k) list[k] = -3.0e38f;
#pragma unroll
    for (int i = 0; i < 16; ++i)
#pragma unroll
      for (int j = 0; j < 16; ++j)
        if ((i + 1) * (j + 1) <= 16) {
          const float cs = s1[i] + s2[j];
          const float v = __uint_as_float((__float_as_uint(cs) & ~255u) | (unsigned)(i * 16 + j));
          INS16(list, v);
        }
    float ex[16], sum = 0.f;
#pragma unroll
    for (int k = 0; k < 16; ++k) { ex[k] = __expf(list[k] - list[0]); sum += ex[k]; }
    const float inv = 1.f / sum;
#pragma unroll
    for (int k = 0; k < 16; ++k) {
      const unsigned bits = __float_as_uint(list[k]);
      const int i = (bits >> 4) & 15, j = bits & 15;
      const int idx = hh * 16 + k;
      const int pos = (idx & 7) * 16 + (idx >> 3);
      SELE[(size_t)tok * 128 + pos] = (unsigned short)(tab[i] * 128 + tab[16 + j]);
      SELG[(size_t)tok * 128 + pos] = ex[k] * inv;
    }
  }
  {
    const bf16_t* H2 = (const bf16_t*)(p.ws + OFF_PRG);
    float* HSC = (float*)(p.ws + OFF_HSC);
    for (int tok = blockIdx.x * 8 + w; tok < RLAT; tok += gridDim.x * 8) {
      const u32x4 a = *(const u32x4*)(H2 + (size_t)tok * 1024 + lane * 16);
      const u32x4 b = *(const u32x4*)(H2 + (size_t)tok * 1024 + lane * 16 + 8);
      float v[16];
#pragma unroll
      for (int m = 0; m < 4; ++m) {
        v[2 * m] = __uint_as_float(a[m] << 16); v[2 * m + 1] = __uint_as_float(a[m] & 0xffff0000u);
        v[8 + 2 * m] = __uint_as_float(b[m] << 16); v[8 + 2 * m + 1] = __uint_as_float(b[m] & 0xffff0000u);
      }
      float am = 0.f;
#pragma unroll
      for (int j = 0; j < 16; ++j) am = fmaxf(am, fabsf(v[j]));
#pragma unroll
      for (int o = 32; o > 0; o >>= 1) am = fmaxf(am, __shfl_xor(am, o, 64));
      am = fmaxf(am, 1e-30f);
      const float inv = 127.f / am;
      u32x4 pk;
#pragma unroll
      for (int m = 0; m < 4; ++m) {
        const unsigned q0 = (unsigned)((int)rintf(v[4 * m] * inv)) & 255u;
        const unsigned q1 = (unsigned)((int)rintf(v[4 * m + 1] * inv)) & 255u;
        const unsigned q2 = (unsigned)((int)rintf(v[4 * m + 2] * inv)) & 255u;
        const unsigned q3 = (unsigned)((int)rintf(v[4 * m + 3] * inv)) & 255u;
        pk[m] = q0 | (q1 << 8) | (q2 << 16) | (q3 << 24);
      }
      *(u32x4*)(p.ws + OFF_HQ + (size_t)tok * 1024 + lane * 16) = pk;
      if (lane == 0) HSC[tok] = am * (1.f / 127.f);
    }
  }
}

__device__ void phase_peer_udot(const Params& p) {
  const int lane = threadIdx.x & 63, w = threadIdx.x >> 6;
  const int g = lane >> 3, part = lane & 7;
  const unsigned short* SELE = (const unsigned short*)(p.ws + OFF_SELE);
  short* PD = (short*)(p.ws + OFF_PD);
  for (int item = blockIdx.x; item < 256; item += gridDim.x) {
    const int x = item & 7, lb = item >> 3;
    const unsigned char* US = p.ws + OFF_UQ + (size_t)x * 2097152 + part * 16;
    for (int t = 0; t < 128; ++t) {
      const int tok = lb * 1024 + w * 128 + t;
      const u32x4 hq = *(const u32x4*)(p.ws + OFF_HQ + (size_t)tok * 1024 + x * 128 + part * 16);
      int eid[16];
#pragma unroll
      for (int m = 0; m < 2; ++m) {
        const u32x4 e4 = *(const u32x4*)(SELE + (size_t)tok * 128 + g * 16 + m * 8);
#pragma unroll
        for (int q = 0; q < 4; ++q) { eid[8 * m + 2 * q] = (int)(e4[q] & 0xffffu); eid[8 * m + 2 * q + 1] = (int)(e4[q] >> 16); }
      }
      u32x4 uq[16];
#pragma unroll
      for (int it = 0; it < 16; ++it) uq[it] = *(const u32x4*)(US + (size_t)eid[it] * 128);
      int d0 = 0, d1 = 0;
#pragma unroll
      for (int it = 0; it < 16; ++it) {
        int d = __builtin_amdgcn_sdot4((int)uq[it][0], (int)hq[0], 0, false);
        d = __builtin_amdgcn_sdot4((int)uq[it][1], (int)hq[1], d, false);
        d = __builtin_amdgcn_sdot4((int)uq[it][2], (int)hq[2], d, false);
        d = __builtin_amdgcn_sdot4((int)uq[it][3], (int)hq[3], d, false);
        d += __builtin_amdgcn_update_dpp(0, d, 0xB1, 0xf, 0xf, false);
        d += __builtin_amdgcn_update_dpp(0, d, 0x4E, 0xf, 0xf, false);
        d += __builtin_amdgcn_update_dpp(0, d, 0x141, 0xf, 0xf, false);
        if (it < 8) { if (part == it) d0 = d; } else { if (part == it - 8) d1 = d; }
      }
      short* dst = PD + ((size_t)x * 32768 + tok) * 128 + g * 16 + part;
      dst[0] = (short)((d0 + 32) >> 6);
      dst[8] = (short)((d1 + 32) >> 6);
    }
  }
}

__device__ void phase_peer_coef(const Params& p) {
  const int lane = threadIdx.x & 63, w = threadIdx.x >> 6;
  const unsigned short* SELE = (const unsigned short*)(p.ws + OFF_SELE);
  const float* SELG = (const float*)(p.ws + OFF_SELG);
  const short* PD = (const short*)(p.ws + OFF_PD);
  const float* SU = (const float*)(p.ws + OFF_SUV);
  const float* SV = SU + 16384;
  const float* HSC = (const float*)(p.ws + OFF_HSC);
  unsigned char* CQ = p.ws + OFF_CQ;
  float* CSC = (float*)(p.ws + OFF_CSC);
  for (int tok0 = (blockIdx.x * 8 + w) * 4; tok0 < RLAT; tok0 += gridDim.x * 32) {
    int e[4][2], ds[4][2];
    float gt[4][2], hs[4];
#pragma unroll
    for (int tt = 0; tt < 4; ++tt) {
      const int tok = tok0 + tt;
      hs[tt] = HSC[tok];
#pragma unroll
      for (int q = 0; q < 2; ++q) {
        const int pos = lane + 64 * q;
        e[tt][q] = (int)SELE[(size_t)tok * 128 + pos];
        gt[tt][q] = SELG[(size_t)tok * 128 + pos];
        int s = 0;
#pragma unroll
        for (int x = 0; x < 8; ++x) s += (int)PD[((size_t)x * 32768 + tok) * 128 + pos];
        ds[tt][q] = s * 64;
      }
    }
    float su[4][2], sv[4][2];
#pragma unroll
    for (int tt = 0; tt < 4; ++tt)
#pragma unroll
      for (int q = 0; q < 2; ++q) { su[tt][q] = SU[e[tt][q]]; sv[tt][q] = SV[e[tt][q]]; }
#pragma unroll
    for (int tt = 0; tt < 4; ++tt) {
      const int tok = tok0 + tt;
      float coef[2];
#pragma unroll
      for (int q = 0; q < 2; ++q) {
        const float dot = su[tt][q] * hs[tt] * (float)ds[tt][q];
        coef[q] = gt[tt][q] * gelu_tanh(dot) * sv[tt][q];
      }
      float am = fmaxf(fabsf(coef[0]), fabsf(coef[1]));
#pragma unroll
      for (int o = 32; o > 0; o >>= 1) am = fmaxf(am, __shfl_xor(am, o, 64));
      am = fmaxf(am, 1e-30f);
      const float inv = 127.f / am;
      CQ[(size_t)tok * 128 + lane] = (unsigned char)((int)rintf(coef[0] * inv) & 255);
      CQ[(size_t)tok * 128 + 64 + lane] = (unsigned char)((int)rintf(coef[1] * inv) & 255);
      if (lane == 0) CSC[tok] = am * (1.f / 127.f);
    }
  }
}

__device__ void phase_peer_vacc(const Params& p, unsigned char* smem) {
  const int lane = threadIdx.x & 63, w = threadIdx.x >> 6;
  const int g = lane >> 3, part = lane & 7;
  const unsigned short* SELE = (const unsigned short*)(p.ws + OFF_SELE);
  const float* CSC = (const float*)(p.ws + OFF_CSC);
  for (int item = blockIdx.x; item < 256; item += gridDim.x) {
    const int x = item & 7, lb = item >> 3;
    const unsigned char* VS = p.ws + OFF_VQ + (size_t)x * 2097152 + part * 16;
    for (int t = 0; t < 128; ++t) {
      const int tok = lb * 1024 + w * 128 + t;
      const u32x4 cq = *(const u32x4*)(p.ws + OFF_CQ + (size_t)tok * 128 + g * 16);
      int eid[16];
#pragma unroll
      for (int m = 0; m < 2; ++m) {
        const u32x4 e4 = *(const u32x4*)(SELE + (size_t)tok * 128 + g * 16 + m * 8);
#pragma unroll
        for (int q = 0; q < 4; ++q) { eid[8 * m + 2 * q] = (int)(e4[q] & 0xffffu); eid[8 * m + 2 * q + 1] = (int)(e4[q] >> 16); }
      }
      u32x4 vq[16];
#pragma unroll
      for (int it = 0; it < 16; ++it) vq[it] = *(const u32x4*)(VS + (size_t)eid[it] * 128);
      int acc[16];
#pragma unroll
      for (int j = 0; j < 16; ++j) acc[j] = 0;
#pragma unroll
      for (int m = 0; m < 4; ++m) {
#pragma unroll
        for (int c4 = 0; c4 < 4; ++c4) {
          const unsigned a = vq[4 * m][c4], b = vq[4 * m + 1][c4], c = vq[4 * m + 2][c4], d = vq[4 * m + 3][c4];
          const unsigned ab_lo = __builtin_amdgcn_perm(a, b, 0x01050004u), ab_hi = __builtin_amdgcn_perm(a, b, 0x03070206u);
          const unsigned cd_lo = __builtin_amdgcn_perm(c, d, 0x01050004u), cd_hi = __builtin_amdgcn_perm(c, d, 0x03070206u);
          const unsigned col0 = __builtin_amdgcn_perm(ab_lo, cd_lo, 0x01000504u), col1 = __builtin_amdgcn_perm(ab_lo, cd_lo, 0x03020706u);
          const unsigned col2 = __builtin_amdgcn_perm(ab_hi, cd_hi, 0x01000504u), col3 = __builtin_amdgcn_perm(ab_hi, cd_hi, 0x03020706u);
          acc[4 * c4 + 0] = __builtin_amdgcn_sdot4((int)col0, (int)cq[m], acc[4 * c4 + 0], false);
          acc[4 * c4 + 1] = __builtin_amdgcn_sdot4((int)col1, (int)cq[m], acc[4 * c4 + 1], false);
          acc[4 * c4 + 2] = __builtin_amdgcn_sdot4((int)col2, (int)cq[m], acc[4 * c4 + 2], false);
          acc[4 * c4 + 3] = __builtin_amdgcn_sdot4((int)col3, (int)cq[m], acc[4 * c4 + 3], false);
        }
      }
      int* red = (int*)smem + w * 1024;
#pragma unroll
      for (int m = 0; m < 4; ++m) {
        u32x4 t4;
        t4[0] = (unsigned)acc[4 * m]; t4[1] = (unsigned)acc[4 * m + 1]; t4[2] = (unsigned)acc[4 * m + 2]; t4[3] = (unsigned)acc[4 * m + 3];
        *(u32x4*)(red + m * 256 + lane * 4) = t4;
      }
      int s0 = 0, s1 = 0;
#pragma unroll
      for (int gg = 0; gg < 8; ++gg) {
        const uint2 t2 = *(const uint2*)(red + (g >> 1) * 256 + (gg * 8 + part) * 4 + (g & 1) * 2);
        s0 += (int)t2.x;
        s1 += (int)t2.y;
      }
      const float cs = CSC[tok];
      const int col = x * 128 + part * 16 + 2 * g;
      *(unsigned*)((bf16_t*)(p.ws + OFF_QG) + (size_t)tok * 1024 + col) = pack2(cs * (float)s0, cs * (float)s1);
    }
  }
}

__device__ void phase_final_norm(const Params& p) {
  const int lane = threadIdx.x & 63, w = threadIdx.x >> 6;
  const float* mod = (const float*)(p.ws + OFF_MOD);
  const bf16_t* PB = (const bf16_t*)(p.ws + OFF_QG);
  for (int tok = blockIdx.x * 8 + w; tok < RLAT; tok += gridDim.x * 8) {
    const int bb = tok >> 12;
    float* xr = p.out + (size_t)tok * 1024;
    f32x4 v[4];
    float s = 0.f;
#pragma unroll
    for (int m = 0; m < 4; ++m) {
      const int col = (m * 64 + lane) * 4;
      v[m] = *(const f32x4*)(xr + col);
      const uint2 pk = *(const uint2*)(PB + (size_t)tok * 1024 + col);
      const f32x4 gv = *(const f32x4*)(mod + bb * 6144 + 5120 + col);
      v[m][0] += gv[0] * __uint_as_float(pk.x << 16);
      v[m][1] += gv[1] * __uint_as_float(pk.x & 0xffff0000u);
      v[m][2] += gv[2] * __uint_as_float(pk.y << 16);
      v[m][3] += gv[3] * __uint_as_float(pk.y & 0xffff0000u);
      s += v[m][0] * v[m][0] + v[m][1] * v[m][1] + v[m][2] * v[m][2] + v[m][3] * v[m][3];
    }
    s = wave_sum(s);
    const float rs = rsqrtf(s * (1.f / 1024.f) + 1e-6f);
#pragma unroll
    for (int m = 0; m < 4; ++m) {
      const int col = (m * 64 + lane) * 4;
      const f32x4 fg = *(const f32x4*)(p.final_g + col);
      f32x4 o = v[m];
      o[0] *= rs * fg[0]; o[1] *= rs * fg[1]; o[2] *= rs * fg[2]; o[3] *= rs * fg[3];
      *(f32x4*)(xr + col) = o;
    }
  }
}

constexpr size_t OFF_BAR = WS_END + 8388608;
#define XB_TMO      128
#define XB_XCNT(j)  (256  + 64 * (j))
#define XB_XSUB(j)  (1280 + 64 * (j))
#define XB_XGEN(j)  (2304 + 64 * (j))
#define XB_TOP      3328
#define XB_TOPGEN   3392
#define XCD_BAR_WORDS 3456
#define XB_SPIN_CAP (1u << 18)
#define LAS __attribute__((address_space(3)))
__device__ __forceinline__ unsigned xb_ld(unsigned* p)              { return __hip_atomic_load(p, __ATOMIC_RELAXED, __HIP_MEMORY_SCOPE_AGENT); }
__device__ __forceinline__ unsigned xb_add(unsigned* p, unsigned v) { return __hip_atomic_fetch_add(p, v, __ATOMIC_RELAXED, __HIP_MEMORY_SCOPE_AGENT); }
__device__ __forceinline__ unsigned xb_xcc_id() { return (unsigned)__builtin_amdgcn_s_getreg((3 << 11) | 20) & 0xFu; }
#define XB_SPIN(cond, bar) do { unsigned _sp = 0; while (cond) { __builtin_amdgcn_s_sleep(1); \
    if ((++_sp & 255u) == 0u) { if (xb_ld(&(bar)[XB_TMO])) break; if (_sp > XB_SPIN_CAP) { atomicAdd(&(bar)[XB_TMO], 1u); break; } } } } while (0)
struct XcdBarrier { unsigned* bar; unsigned x; volatile LAS unsigned* st; };
__device__ __forceinline__ XcdBarrier xcd_barrier_post(unsigned* bar, volatile LAS unsigned* st) {
  XcdBarrier b; b.bar = bar; b.x = xb_xcc_id(); b.st = st;
  if (threadIdx.x == 0) (void)xb_add(&bar[XB_XCNT(b.x)], 1u);
  return b;
}
__device__ __forceinline__ void xcd_barrier_complete(unsigned* bar, unsigned x, unsigned& nloc, unsigned& nx) {
  const unsigned G = gridDim.x * gridDim.y * gridDim.z;
  unsigned sum, cnt, mine, sp = 0u;
  for (;;) {
    sum = 0u; cnt = 0u; mine = 0u;
#pragma unroll
    for (unsigned j = 0; j < 16; ++j) { const unsigned c = xb_ld(&bar[XB_XCNT(j)]); sum += c; cnt += (c > 0u) ? 1u : 0u; mine = (j == x) ? c : mine; }
    if (sum == G) break;
    __builtin_amdgcn_s_sleep(1);
    if ((++sp & 255u) == 0u) { if (xb_ld(&bar[XB_TMO])) break; if (sp > XB_SPIN_CAP) { atomicAdd(&bar[XB_TMO], 1u); break; } }
  }
  nloc = mine > 0u ? mine : 1u; nx = cnt > 0u ? cnt : 1u;
}
__device__ __forceinline__ void xcd_barrier(const XcdBarrier& b) {
  asm volatile("s_waitcnt vmcnt(0)" ::: "memory");
  __syncthreads();
  if (threadIdx.x == 0) {
    unsigned* bar = b.bar;
    __builtin_amdgcn_s_waitcnt(0);
    unsigned nloc = b.st[0], nx = b.st[1];
    if (nloc == 0u) { xcd_barrier_complete(bar, b.x, nloc, nx); b.st[0] = nloc; b.st[1] = nx; }
    const unsigned old = xb_add(&bar[XB_XSUB(b.x)], 1u);
    const unsigned gen = old / nloc;
    if (old + 1u == (gen + 1u) * nloc) {
      __builtin_amdgcn_fence(__ATOMIC_RELEASE, "agent");
      asm volatile("s_waitcnt vmcnt(0)" ::: "memory");
      const unsigned og = xb_add(&bar[XB_TOP], 1u);
      const unsigned tg = og / nx;
      if (og + 1u == (tg + 1u) * nx) xb_add(&bar[XB_TOPGEN], 1u);
      else XB_SPIN(xb_ld(&bar[XB_TOPGEN]) == tg, bar);
      __builtin_amdgcn_fence(__ATOMIC_ACQUIRE, "agent");
      xb_add(&bar[XB_XGEN(b.x)], 1u);
      asm volatile("s_waitcnt vmcnt(0)" ::: "memory");
    } else {
      XB_SPIN(xb_ld(&bar[XB_XGEN(b.x)]) == gen, bar);
      __builtin_amdgcn_fence(__ATOMIC_ACQUIRE, "agent");
      asm volatile("s_waitcnt vmcnt(0)" ::: "memory");
    }
  }
  __syncthreads();
}

#ifndef PROBE_REP
#define PROBE_REP 0
#endif
__global__ void __launch_bounds__(NT) mega(Params p) {
  extern __shared__ __align__(16) unsigned char smem[];
  cg::grid_group grid = cg::this_grid();
  volatile LAS unsigned* xst = (volatile LAS unsigned*)(smem + LDS_BYTES - 16);
  if (threadIdx.x == 0) { xst[0] = 0u; xst[1] = 0u; }
  __syncthreads();
  const XcdBarrier xbar = xcd_barrier_post((unsigned*)(p.ws + OFF_BAR), xst);
  if (p.ph_lo > 1000) grid.sync();
#define PH(i) (p.ph_lo <= (i) && (i) < p.ph_hi)
#define SYNC(i) if (PH(i) && PH((i) + 1)) xcd_barrier(xbar);
#define RUN(i, body)                                         \
  if (PH(i)) {                                               \
    const int nrep_ = 1 + ((p.rep_mask >> (i)) & 1);         \
    for (int rep_ = 0; rep_ < nrep_; ++rep_) {               \
      if (rep_) xcd_barrier(xbar);                           \
      body;                                                  \
    }                                                        \
  }                                                          \
  SYNC(i)
#define RUN1(i, body) if (PH(i)) { body; } SYNC(i)
  RUN(0, phase0(p, smem))
  RUN(1, norm_mod_rows(p.x, p.ctx, RALL, p.norm1_g, (const float*)(p.ws + OFF_MOD), 0, 1024, (bf16_t*)(p.ws + OFF_KC)))
  RUN(2, phase_inproj(p, smem))
  RUN1(3, {
    u32x4 pr[7];
    float pf[5];
    int item = blockIdx.x;
    if (item < 2176) prepass_preload(p, item, pr, pf);
    for (; item < 2176; item += gridDim.x) gdn_prepass_item(p, item, item + gridDim.x, smem, pr, pf); })
  RUN1(4, {
    const int item = blockIdx.x;
    if (item < 128) gdn_seq_item(p, item, smem);
    else if (item < 256) rglru_item(p, item - 128, smem); })
  RUN(5, { phase_ya(p); phase_quant_uv(p); })
  RUN(6, phase_outproj(p, smem))
  RUN(7, norm_mod_rows(p.out, p.out, RLAT, p.norm2_g, (const float*)(p.ws + OFF_MOD), 3072, 4096, (bf16_t*)(p.ws + OFF_PRG)))
  RUN(8, phase_peer_query(p, smem))
  RUN1(9, phase_peer_select(p, smem))
  RUN1(10, phase_peer_udot(p))
  RUN1(11, phase_peer_coef(p))
  RUN1(12, phase_peer_vacc(p, smem))
  if (PH(13)) phase_final_norm(p);
}

extern "C" void kernel_launch(void* const* d_in, const int* in_sizes, int n_in, void* d_out, int out_size,
                              void* d_ws, size_t ws_size, hipStream_t stream) {
  static int grid_blocks = 0;
  if (grid_blocks == 0) {
    if (ws_size < OFF_BAR + 16384) { fprintf(stderr, "workspace too small: %zu < %zu\n", ws_size, (size_t)WS_END); grid_blocks = -1; return; }
    int dev = 0, cus = 0, per_cu = 0;
    hipGetDevice(&dev);
    hipDeviceGetAttribute(&cus, hipDeviceAttributeMultiprocessorCount, dev);
    if (hipFuncSetAttribute((const void*)mega, hipFuncAttributeMaxDynamicSharedMemorySize, LDS_BYTES) != hipSuccess) {
      fprintf(stderr, "hipFuncSetAttribute failed\n"); grid_blocks = -1; return;
    }
    hipOccupancyMaxActiveBlocksPerMultiprocessor(&per_cu, (const void*)mega, NT, LDS_BYTES);
    if (per_cu < 1) { fprintf(stderr, "occupancy query says %d\n", per_cu); per_cu = 1; }
    (void)hipGetLastError();
    grid_blocks = cus * per_cu;
    if (grid_blocks < 256) { fprintf(stderr, "grid %d < 256: scan phase needs 256 resident blocks\n", grid_blocks); grid_blocks = -1; return; }
  }
  if (grid_blocks < 0) return;
  Params p{};
  const float** pp = (const float**)&p;
  for (int i = 0; i < 24; ++i) pp[i] = (const float*)d_in[i];
  p.out = (float*)d_out;
  p.ws = (unsigned char*)d_ws;
  p.ph_lo = 0;
  p.ph_hi = 14;
  p.rep_mask = PROBE_REP;
  if (hipMemsetAsync((char*)d_ws + OFF_BAR, 0, 16384, stream) != hipSuccess) { fprintf(stderr, "barrier memset failed\n"); return; }
  void* args[] = {&p};
  hipError_t e = hipLaunchCooperativeKernel((const void*)mega, dim3(grid_blocks), dim3(NT), args, LDS_BYTES, stream);
  if (e != hipSuccess) fprintf(stderr, "cooperative launch failed: %s (grid %d)\n", hipGetErrorString(e), grid_blocks);
}
```

```cpp
#include <hip/hip_runtime.h>
#include <hip/hip_cooperative_groups.h>
#include <cstdio>
namespace cg = cooperative_groups;

#define NT 512
typedef __attribute__((ext_vector_type(8))) short bf16x8;
typedef __attribute__((ext_vector_type(16))) float f32x16;
typedef __attribute__((ext_vector_type(4))) float f32x4;
typedef unsigned short bf16_t;
typedef unsigned u32x4 __attribute__((ext_vector_type(4)));

#define MFMA32(a, b, c) __builtin_amdgcn_mfma_f32_32x32x16_bf16((a), (b), (c), 0, 0, 0)
#define MFMA16(a, b, c) __builtin_amdgcn_mfma_f32_16x16x32_bf16((a), (b), (c), 0, 0, 0)

constexpr int RLAT = 32768, RALL = 34816;
constexpr int LDS_BYTES = 155648;
constexpr int NCHUNK = 4352;

constexpr size_t OFF_MOD = 0;
constexpr size_t OFF_WIN = OFF_MOD + 221184;
constexpr size_t OFF_WOUT = OFF_WIN + 6815744;
constexpr size_t OFF_WQ = OFF_WOUT + 2097152;
constexpr size_t OFF_KEYS = OFF_WQ + 4194304;
constexpr size_t OFF_PRG = OFF_KEYS + 65536;
constexpr size_t OFF_PQKV = OFF_PRG + 71303168;
constexpr size_t OFF_PZ = OFF_PQKV + 106954752;
constexpr size_t OFF_PAB = OFF_PZ + 35651584;
constexpr size_t OFF_QG = OFF_PAB + 2228224;
constexpr size_t OFF_KDT = OFF_QG + 71303168;
constexpr size_t OFF_KC = OFF_KDT + 71303168;
constexpr size_t OFF_EGL = OFF_KC + 71303168;
constexpr size_t OFF_H = OFF_EGL + 17408;
constexpr size_t WS_END = OFF_H + 67108864;
constexpr size_t OUT_WV = 0;
constexpr size_t OUT_AT = 71303168;

struct Params {
  const float *x, *c, *ctx, *c_ctx, *w_mod, *b_mod, *norm1_g, *norm2_g, *w_in, *rg_conv_w, *rg_conv_b,
      *rg_gate_w, *rg_gate_b, *rg_lambda, *gdn_conv_w, *gdn_a_log, *gdn_dt_bias, *gdn_norm_g, *w_out,
      *peer_wq, *peer_keys, *peer_u, *peer_v, *final_g;
  float* out;
  unsigned char* ws;
  int ph_lo, ph_hi;
  int rep_mask, pad_;
};

__device__ __forceinline__ bf16_t f2bf(float f) {
  unsigned u = __float_as_uint(f);
  u += 0x7fffu + ((u >> 16) & 1u);
  return (bf16_t)(u >> 16);
}
__device__ __forceinline__ float bf2f(bf16_t b) { return __uint_as_float(((unsigned)b) << 16); }
__device__ __forceinline__ unsigned pack2(float a, float b) { return (unsigned)f2bf(a) | ((unsigned)f2bf(b) << 16); }
__device__ __forceinline__ float wave_sum(float v) {
#pragma unroll
  for (int o = 32; o > 0; o >>= 1) v += __shfl_xor(v, o, 64);
  return v;
}
__device__ __forceinline__ float sigmoidf_(float x) { return 1.f / (1.f + __expf(-x)); }
__device__ __forceinline__ float siluf_(float x) { return x / (1.f + __expf(-x)); }
__device__ __forceinline__ float softplusf_(float x) { return fmaxf(x, 0.f) + log1pf(__expf(-fabsf(x))); }
__device__ __forceinline__ float gelu_tanh(float x) {
  float y = 0.7978845608028654f * (x + 0.044715f * x * x * x);
  return 0.5f * x * (1.f + tanhf(y));
}

__device__ void transpose_tile(const float* W, int N, bf16_t* Wt, int kt, int nt, float* tile) {
  const int tid = threadIdx.x;
  const int k0 = kt * 64, n0 = nt * 64;
#pragma unroll
  for (int i = 0; i < 8; ++i) {
    int r = i * 8 + (tid >> 6), cc = tid & 63, n = n0 + cc;
    tile[r * 65 + cc] = (n < N) ? W[(size_t)(k0 + r) * N + n] : 0.f;
  }
  __syncthreads();
#pragma unroll
  for (int i = 0; i < 8; ++i) {
    int r = i * 8 + (tid >> 6), cc = tid & 63;
    Wt[(size_t)(n0 + r) * 1024 + k0 + cc] = f2bf(tile[cc * 65 + r]);
  }
  __syncthreads();
}

__device__ void phase0(const Params& p, unsigned char* smem) {
  const int tid = threadIdx.x;
  float* mod = (float*)(p.ws + OFF_MOD);
  const int nitems = 96 + 832 + 256 + 512 + 1;
  for (int item = blockIdx.x; item < nitems; item += gridDim.x) {
    if (item < 96) {
      float* sc = (float*)smem;
      float* red = sc + 9 * 1024;
      for (int i = tid; i < 9 * 1024; i += NT) {
        int row = i >> 10, k = i & 1023;
        float v = row < 8 ? p.c[row * 1024 + k] : p.c_ctx[k];
        sc[i] = siluf_(v);
      }
      __syncthreads();
      const int w = tid >> 6, lane = tid & 63;
      const int col = item * 64 + lane;
      float acc[9];
#pragma unroll
      for (int r = 0; r < 9; ++r) acc[r] = 0.f;
      const float* wp = p.w_mod + (size_t)(w * 128) * 6144 + col;
#pragma unroll 8
      for (int k = 0; k < 128; ++k) {
        float wv = wp[(size_t)k * 6144];
#pragma unroll
        for (int r = 0; r < 9; ++r) acc[r] += sc[r * 1024 + w * 128 + k] * wv;
      }
#pragma unroll
      for (int r = 0; r < 9; ++r) red[(w * 9 + r) * 64 + lane] = acc[r];
      __syncthreads();
      for (int i = tid; i < 9 * 64; i += NT) {
        int r = i >> 6, l = i & 63;
        float s = 0.f;
        for (int ww = 0; ww < 8; ++ww) s += red[(ww * 9 + r) * 64 + l];
        int cc = item * 64 + l;
        mod[r * 6144 + cc] = s + p.b_mod[cc];
      }
      __syncthreads();
    } else if (item < 96 + 832) {
      int it = item - 96;
      transpose_tile(p.w_in, 3088, (bf16_t*)(p.ws + OFF_WIN), it & 15, it >> 4, (float*)smem);
    } else if (item < 96 + 832 + 256) {
      int it = item - 928;
      transpose_tile(p.w_out, 1024, (bf16_t*)(p.ws + OFF_WOUT), it & 15, it >> 4, (float*)smem);
    } else if (item < 96 + 832 + 256 + 512) {
      int it = item - 1184;
      transpose_tile(p.peer_wq, 2048, (bf16_t*)(p.ws + OFF_WQ), it & 15, it >> 4, (float*)smem);
    } else {
      bf16_t* kb = (bf16_t*)(p.ws + OFF_KEYS);
      for (int i = tid; i < 2 * 128 * 128; i += NT) kb[i] = f2bf(p.peer_keys[i]);
    }
  }
}

__device__ void norm_mod_rows(const float* src_lat, const float* src_ctx, int nrows, const float* g,
                              const float* mod, int sh_off, int sc_off, bf16_t* dst) {
  const int lane = threadIdx.x & 63, w = threadIdx.x >> 6;
  for (int row = blockIdx.x * 8 + w; row < nrows; row += gridDim.x * 8) {
    const float* xr = row < RLAT ? src_lat + (size_t)row * 1024 : src_ctx + (size_t)(row - RLAT) * 1024;
    const int bb = row < RLAT ? (row >> 12) : 8;
    float4 v[4];
    float ss = 0.f;
#pragma unroll
    for (int m = 0; m < 4; ++m) {
      v[m] = ((const float4*)xr)[m * 64 + lane];
      ss += v[m].x * v[m].x + v[m].y * v[m].y + v[m].z * v[m].z + v[m].w * v[m].w;
    }
    ss = wave_sum(ss);
    const float rstd = rsqrtf(ss * (1.f / 1024.f) + 1e-6f);
#pragma unroll
    for (int m = 0; m < 4; ++m) {
      const int col = (m * 64 + lane) * 4;
      float4 gg = *(const float4*)(g + col);
      float4 sh = *(const float4*)(mod + bb * 6144 + sh_off + col);
      float4 sc = *(const float4*)(mod + bb * 6144 + sc_off + col);
      float y0 = v[m].x * rstd * gg.x * (1.f + sc.x) + sh.x;
      float y1 = v[m].y * rstd * gg.y * (1.f + sc.y) + sh.y;
      float y2 = v[m].z * rstd * gg.z * (1.f + sc.z) + sh.z;
      float y3 = v[m].w * rstd * gg.w * (1.f + sc.w) + sh.w;
      uint2 o;
      o.x = pack2(y0, y1);
      o.y = pack2(y2, y3);
      *(uint2*)(dst + (size_t)row * 1024 + col) = o;
    }
  }
}

__device__ __forceinline__ void gemm_tile(const bf16_t* A, const bf16_t* Bt, f32x16 (&acc)[2][2], unsigned char* smem) {
  const int tid = threadIdx.x, lane = tid & 63, w = tid >> 6;
  const int wm = w >> 1, wn = w & 1;
  const int r = lane & 31, h = lane >> 5;
  u32x4 ra0, ra1, ra2, ra3, rb0, rb1;
#pragma unroll
  for (int i = 0; i < 2; ++i)
#pragma unroll
    for (int j = 0; j < 2; ++j)
#pragma unroll
      for (int q = 0; q < 16; ++q) acc[i][j][q] = 0.f;
  const int srow = tid >> 3, scol = (tid & 7) * 8;
  const bf16_t* Ag = A + (size_t)srow * 1024 + scol;
  const bf16_t* Bg = Bt + (size_t)srow * 1024 + scol;
  const int soff = (srow * 72 + scol) * 2;
#define GLOAD(kt_)                                                   \
  ra0 = *(const u32x4*)(Ag + (kt_) * 64);                            \
  ra1 = *(const u32x4*)(Ag + (size_t)64 * 1024 + (kt_) * 64);        \
  ra2 = *(const u32x4*)(Ag + (size_t)128 * 1024 + (kt_) * 64);       \
  ra3 = *(const u32x4*)(Ag + (size_t)192 * 1024 + (kt_) * 64);       \
  rb0 = *(const u32x4*)(Bg + (kt_) * 64);                            \
  rb1 = *(const u32x4*)(Bg + (size_t)64 * 1024 + (kt_) * 64);
#define SSTORE(buf_)                                                        \
  {                                                                         \
    unsigned char* sb_ = smem + (buf_) * 55296 + soff;                      \
    *(u32x4*)(sb_) = ra0;                                                   \
    *(u32x4*)(sb_ + 64 * 144) = ra1;                                        \
    *(u32x4*)(sb_ + 128 * 144) = ra2;                                       \
    *(u32x4*)(sb_ + 192 * 144) = ra3;                                       \
    *(u32x4*)(sb_ + 36864) = rb0;                                           \
    *(u32x4*)(sb_ + 36864 + 64 * 144) = rb1;                                \
  }
  GLOAD(0)
  __syncthreads();
  SSTORE(0)
  GLOAD(1)
  __syncthreads();
#define KSTEP(ks)                                                                          \
  {                                                                                        \
    bf16x8 a0 = *(const bf16x8*)(As + (wm * 64 + r) * 72 + (ks) * 16 + h * 8);             \
    bf16x8 a1 = *(const bf16x8*)(As + (wm * 64 + 32 + r) * 72 + (ks) * 16 + h * 8);        \
    bf16x8 b0 = *(const bf16x8*)(Bs + (wn * 64 + r) * 72 + (ks) * 16 + h * 8);             \
    bf16x8 b1 = *(const bf16x8*)(Bs + (wn * 64 + 32 + r) * 72 + (ks) * 16 + h * 8);        \
    acc[0][0] = MFMA32(a0, b0, acc[0][0]);                                                 \
    acc[0][1] = MFMA32(a0, b1, acc[0][1]);                                                 \
    acc[1][0] = MFMA32(a1, b0, acc[1][0]);                                                 \
    acc[1][1] = MFMA32(a1, b1, acc[1][1]);                                                 \
  }
  for (int kt = 0; kt < 16; ++kt) {
    const int cur = kt & 1;
    const bf16_t* As = (const bf16_t*)(smem + cur * 55296);
    const bf16_t* Bs = (const bf16_t*)(smem + cur * 55296 + 36864);
    KSTEP(0)
    __builtin_amdgcn_sched_barrier(0);
    if (kt + 1 < 16) SSTORE(cur ^ 1)
    __builtin_amdgcn_sched_barrier(0);
    if (kt + 2 < 16) { GLOAD(kt + 2) }
    __builtin_amdgcn_sched_barrier(0);
    KSTEP(1)
    KSTEP(2)
    KSTEP(3)
    __syncthreads();
  }
#undef KSTEP
#undef GLOAD
#undef SSTORE
}

__device__ __forceinline__ void store_tile_bf16(const f32x16 (&acc)[2][2], unsigned char* smem, bf16_t* dst, size_t ld) {
  const int lane = threadIdx.x & 63, w = threadIdx.x >> 6;
  const int r = lane & 31, h = lane >> 5;
  bf16_t* Cw = (bf16_t*)(smem + w * 9216);
#pragma unroll
  for (int i = 0; i < 2; ++i)
#pragma unroll
    for (int j = 0; j < 2; ++j)
#pragma unroll
      for (int q = 0; q < 16; ++q)
        Cw[(i * 32 + (q & 3) + 8 * (q >> 2) + 4 * h) * 72 + j * 32 + r] = f2bf(acc[i][j][q]);
#pragma unroll
  for (int it = 0; it < 8; ++it) {
    const int row = (lane >> 3) + 8 * it, seg = lane & 7;
    const u32x4 v = *(const u32x4*)(Cw + row * 72 + seg * 8);
    *(u32x4*)(dst + (size_t)row * ld + seg * 8) = v;
  }
}

__device__ __forceinline__ void gemm_tile256(const bf16_t* A, const bf16_t* Bt, f32x16 (&acc)[4][2], unsigned char* smem) {
  const int tid = threadIdx.x, lane = tid & 63, w = tid >> 6;
  const int wm = w >> 2, wn = w & 3;
  const int r = lane & 31, h = lane >> 5;
  u32x4 ra0, ra1, ra2, ra3, rb0, rb1, rb2, rb3;
#pragma unroll
  for (int i = 0; i < 4; ++i)
#pragma unroll
    for (int j = 0; j < 2; ++j)
#pragma unroll
      for (int q = 0; q < 16; ++q) acc[i][j][q] = 0.f;
  const int srow = tid >> 3, scol = (tid & 7) * 8;
  const bf16_t* Ag = A + (size_t)srow * 1024 + scol;
  const bf16_t* Bg = Bt + (size_t)srow * 1024 + scol;
  const int soff = (srow * 72 + scol) * 2;
#define GLOAD(kt_)                                                   \
  ra0 = *(const u32x4*)(Ag + (kt_) * 64);                            \
  ra1 = *(const u32x4*)(Ag + (size_t)64 * 1024 + (kt_) * 64);        \
  ra2 = *(const u32x4*)(Ag + (size_t)128 * 1024 + (kt_) * 64);       \
  ra3 = *(const u32x4*)(Ag + (size_t)192 * 1024 + (kt_) * 64);       \
  rb0 = *(const u32x4*)(Bg + (kt_) * 64);                            \
  rb1 = *(const u32x4*)(Bg + (size_t)64 * 1024 + (kt_) * 64);        \
  rb2 = *(const u32x4*)(Bg + (size_t)128 * 1024 + (kt_) * 64);       \
  rb3 = *(const u32x4*)(Bg + (size_t)192 * 1024 + (kt_) * 64);
#define SSTORE(buf_)                                                        \
  {                                                                         \
    unsigned char* sb_ = smem + (buf_) * 73728 + soff;                      \
    *(u32x4*)(sb_) = ra0;                                                   \
    *(u32x4*)(sb_ + 64 * 144) = ra1;                                        \
    *(u32x4*)(sb_ + 128 * 144) = ra2;                                       \
    *(u32x4*)(sb_ + 192 * 144) = ra3;                                       \
    *(u32x4*)(sb_ + 36864) = rb0;                                           \
    *(u32x4*)(sb_ + 36864 + 64 * 144) = rb1;                                \
    *(u32x4*)(sb_ + 36864 + 128 * 144) = rb2;                               \
    *(u32x4*)(sb_ + 36864 + 192 * 144) = rb3;                               \
  }
#define KSTEP(ks)                                                                          \
  {                                                                                        \
    bf16x8 b0 = *(const bf16x8*)(Bs + (wn * 64 + r) * 72 + (ks) * 16 + h * 8);             \
    bf16x8 b1 = *(const bf16x8*)(Bs + (wn * 64 + 32 + r) * 72 + (ks) * 16 + h * 8);        \
    bf16x8 a0_ = *(const bf16x8*)(As + (wm * 128 + r) * 72 + (ks) * 16 + h * 8);           \
    bf16x8 a1_ = *(const bf16x8*)(As + (wm * 128 + 32 + r) * 72 + (ks) * 16 + h * 8);      \
    bf16x8 a2_ = *(const bf16x8*)(As + (wm * 128 + 64 + r) * 72 + (ks) * 16 + h * 8);      \
    bf16x8 a3_ = *(const bf16x8*)(As + (wm * 128 + 96 + r) * 72 + (ks) * 16 + h * 8);      \
    __builtin_amdgcn_s_setprio(1);                                                         \
    acc[0][0] = MFMA32(a0_, b0, acc[0][0]); acc[0][1] = MFMA32(a0_, b1, acc[0][1]);        \
    acc[1][0] = MFMA32(a1_, b0, acc[1][0]); acc[1][1] = MFMA32(a1_, b1, acc[1][1]);        \
    acc[2][0] = MFMA32(a2_, b0, acc[2][0]); acc[2][1] = MFMA32(a2_, b1, acc[2][1]);        \
    acc[3][0] = MFMA32(a3_, b0, acc[3][0]); acc[3][1] = MFMA32(a3_, b1, acc[3][1]);        \
    __builtin_amdgcn_s_setprio(0);                                                         \
  }
  GLOAD(0)
  __syncthreads();
  SSTORE(0)
  GLOAD(1)
  __syncthreads();
  for (int kt = 0; kt < 16; ++kt) {
    const int cur = kt & 1;
    const bf16_t* As = (const bf16_t*)(smem + cur * 73728);
    const bf16_t* Bs = (const bf16_t*)(smem + cur * 73728 + 36864);
    KSTEP(0)
    __builtin_amdgcn_sched_barrier(0);
    if (kt + 1 < 16) SSTORE(cur ^ 1)
    __builtin_amdgcn_sched_barrier(0);
    if (kt + 2 < 16) { GLOAD(kt + 2) }
    __builtin_amdgcn_sched_barrier(0);
    KSTEP(1)
    KSTEP(2)
    KSTEP(3)
    __syncthreads();
  }
#undef KSTEP
#undef GLOAD
#undef SSTORE
}

__device__ __forceinline__ void store_half_bf16(const f32x16& a00, const f32x16& a01, const f32x16& a10, const f32x16& a11,
                                                unsigned char* smem, bf16_t* dst, size_t ld) {
  const int lane = threadIdx.x & 63, w = threadIdx.x >> 6;
  const int r = lane & 31, h = lane >> 5;
  bf16_t* Cw = (bf16_t*)(smem + w * 9216);
#pragma unroll
  for (int q = 0; q < 16; ++q) {
    const int rr = (q & 3) + 8 * (q >> 2) + 4 * h;
    Cw[rr * 72 + r] = f2bf(a00[q]);
    Cw[rr * 72 + 32 + r] = f2bf(a01[q]);
    Cw[(32 + rr) * 72 + r] = f2bf(a10[q]);
    Cw[(32 + rr) * 72 + 32 + r] = f2bf(a11[q]);
  }
#pragma unroll
  for (int it = 0; it < 8; ++it) {
    const int row = (lane >> 3) + 8 * it, seg = lane & 7;
    const u32x4 v = *(const u32x4*)(Cw + row * 72 + seg * 8);
    *(u32x4*)(dst + (size_t)row * ld + seg * 8) = v;
  }
}

__device__ void phase_inproj(const Params& p, unsigned char* smem) {
  const bf16_t* XN = (const bf16_t*)(p.ws + OFF_KC);
  const bf16_t* WT = (const bf16_t*)(p.ws + OFF_WIN);
  bf16_t* PRG = (bf16_t*)(p.ws + OFF_PRG);
  bf16_t* PQKV = (bf16_t*)(p.ws + OFF_PQKV);
  bf16_t* PZ = (bf16_t*)(p.ws + OFF_PZ);
  float* PAB = (float*)(p.ws + OFF_PAB);
  const int lane = threadIdx.x & 63, w = threadIdx.x >> 6;
  const int wm = w >> 2, wn = w & 3, r = lane & 31, h = lane >> 5;
  const bool swz = (gridDim.x == 256);
  const int xcd = blockIdx.x & 7;
  const int ntiles = swz ? 17 * 13 : 136 * 13;
  for (int k = swz ? (blockIdx.x >> 3) : blockIdx.x; k < ntiles; k += swz ? 32 : gridDim.x) {
    const int mt = swz ? xcd + 8 * (k / 13) : k / 13, nt = k % 13;
    const int m0 = mt * 256, n0 = nt * 256;
    f32x16 acc[4][2];
    gemm_tile256(XN + (size_t)m0 * 1024, WT + (size_t)n0 * 1024, acc, smem);
    const int nc = n0 + wn * 64;
    if (nc < 3072) {
      bf16_t* dst; size_t ld;
      if (nc < 1024) { dst = PRG + nc; ld = 1024; }
      else if (nc < 2560) { dst = PQKV + (nc - 1024); ld = 1536; }
      else { dst = PZ + (nc - 2560); ld = 512; }
      dst += (size_t)(m0 + wm * 128) * ld;
      store_half_bf16(acc[0][0], acc[0][1], acc[1][0], acc[1][1], smem, dst, ld);
      store_half_bf16(acc[2][0], acc[2][1], acc[3][0], acc[3][1], smem, dst + 64 * ld, ld);
    } else if (nc == 3072 && r < 16) {
#pragma unroll
      for (int i = 0; i < 4; ++i)
#pragma unroll
        for (int q = 0; q < 16; ++q) {
          const size_t grow = m0 + wm * 128 + i * 32 + (q & 3) + 8 * (q >> 2) + 4 * h;
          PAB[grow * 16 + r] = acc[i][0][q];
        }
    }
  }
}

__device__ __forceinline__ int chunk_id(int dir, int b, int h, int ci) { return ((dir * 8 + b) * 4 + h) * 68 + ci; }

typedef __attribute__((address_space(3))) const float lds_cf;
typedef __attribute__((address_space(3))) const bf16_t lds_cb;
typedef __attribute__((address_space(3))) const f32x4 lds_cf4;
typedef __attribute__((address_space(3))) bf16_t lds_b;
template <int DIR, int SRC>
__device__ __forceinline__ void solve_col(lds_cf* A_, lds_cf* vcol, lds_cb* kcol, lds_cf* scale, lds_b* dst) {
  asm volatile("" : "+v"(A_), "+v"(vcol), "+v"(kcol), "+v"(scale), "+v"(dst));
  float sol[64];
#pragma unroll
  for (int i = 0; i < 64; ++i) {
    const int ti = DIR ? 63 - i : i;
    float rv;
    if (SRC == 0) rv = vcol[ti * 128] * scale[i];
    else rv = bf2f(kcol[ti * 136]) * scale[i];
#pragma unroll
    for (int s4 = 0; s4 < (i + 3) / 4; ++s4) {
      const f32x4 a4 = *(lds_cf4*)(A_ + i * 64 + s4 * 4);
      if (s4 * 4 + 0 < i) rv -= a4[0] * sol[s4 * 4 + 0];
      if (s4 * 4 + 1 < i) rv -= a4[1] * sol[s4 * 4 + 1];
      if (s4 * 4 + 2 < i) rv -= a4[2] * sol[s4 * 4 + 2];
      if (s4 * 4 + 3 < i) rv -= a4[3] * sol[s4 * 4 + 3];
    }
    sol[i] = rv;
    dst[i * 256] = f2bf(rv);
    __builtin_amdgcn_sched_barrier(0);
  }
}

__device__ __forceinline__ void prepass_preload(const Params& p, int item, u32x4 (&pr)[7], float (&pf)[5]) {
  int tid = threadIdx.x;
  asm volatile("" : "+v"(tid));
  const bool lat = item < 2048;
  int b, c, h;
  if (lat) { b = item >> 8; c = (item >> 2) & 63; h = item & 3; }
  else { int it = item - 2048; b = it >> 4; c = (it >> 2) & 3; h = it & 3; }
  const int Tseq = lat ? 4096 : 256;
  const bf16_t* PQKV = (const bf16_t*)(p.ws + OFF_PQKV);
  const float* PAB = (const float*)(p.ws + OFF_PAB);
#pragma unroll
  for (int i = 0; i < 7; ++i) {
    const int s = tid + i * NT;
    const int rr = s / 48, q = s % 48;
    const int part = q >> 4, sg = q & 15;
    const int j = c * 64 - 2 + rr;
    u32x4 val = {0u, 0u, 0u, 0u};
    if (s < 67 * 48 && j >= 0 && j < Tseq) {
      const size_t grow = lat ? (size_t)b * 4096 + (size_t)((j & 63) * 64 + (j >> 6)) : (size_t)RLAT + b * 256 + j;
      val = *(const u32x4*)(PQKV + grow * 1536 + part * 512 + h * 128 + sg * 8);
    }
    pr[i] = val;
  }
  pf[0] = 0.f;
}

__device__ __forceinline__ void gdn_prepass_item(const Params& p, int item, int next_item, unsigned char* smem, u32x4 (&pr)[7], float (&pf)[5]) {
  const int tid = threadIdx.x, lane = tid & 63, w = tid >> 6;
  const bool lat = item < 2048;
  int b, c, h;
  if (lat) { b = item >> 8; c = (item >> 2) & 63; h = item & 3; }
  else { int it = item - 2048; b = it >> 4; c = (it >> 2) & 3; h = it & 3; }
  const int Tseq = lat ? 4096 : 256;
  const bf16_t* PQKV = (const bf16_t*)(p.ws + OFF_PQKV);
  const float* PAB = (const float*)(p.ws + OFF_PAB);

  bf16_t* raw = (bf16_t*)smem;
  float* KK = (float*)smem;
  float* QK = KK + 64 * 68;
  bf16_t* qb = (bf16_t*)(smem + 51456);
  bf16_t* kb = qb + 64 * 136;
  float* vf = (float*)(smem + 51456 + 34816);
  float* Am = vf + 64 * 128;
  float* gcs = Am + 2 * 64 * 64;
  float* bet = gcs + 128;
  float* beg = bet + 128;

#pragma unroll
  for (int i = 0; i < 7; ++i) {
    const int s = tid + i * NT;
    if (s < 67 * 48) {
      const int rr = s / 48, q = s % 48;
      *(u32x4*)(raw + rr * 384 + (q >> 4) * 128 + (q & 15) * 8) = pr[i];
    }
  }
  for (int s = tid; s < 4 * 384; s += NT) {
    const int kk = s / 384, q = s % 384;
    Am[s] = p.gdn_conv_w[kk * 1536 + (q >> 7) * 512 + h * 128 + (q & 127)];
  }
  if (tid < 128) {
    const int dir = tid >> 6, i = tid & 63;
    const int tok = dir ? 63 - i : i;
    const int j = c * 64 + tok;
    const size_t grow = lat ? (size_t)b * 4096 + (size_t)((j & 63) * 64 + (j >> 6)) : (size_t)RLAT + b * 256 + j;
    const float a_ = PAB[grow * 16 + dir * 8 + h];
    const float b_ = PAB[grow * 16 + dir * 8 + 4 + h];
    float g = -__expf(p.gdn_a_log[dir * 4 + h]) * softplusf_(a_ + p.gdn_dt_bias[dir * 4 + h]);
    const float be = sigmoidf_(b_);
#pragma unroll
    for (int o = 1; o < 64; o <<= 1) {
      float t = __shfl_up(g, o, 64);
      if (lane >= o) g += t;
    }
    gcs[dir * 64 + i] = g;
    bet[dir * 64 + i] = be;
    beg[dir * 64 + i] = be * __expf(g);
  }
  __syncthreads();
  {
    float* cwL = Am;
    const int i = tid >> 3, sg = tid & 7;
#pragma unroll
    for (int part = 0; part < 3; ++part) {
      float y[16];
#pragma unroll
      for (int d = 0; d < 16; ++d) y[d] = 0.f;
#pragma unroll
      for (int kk = 0; kk < 4; ++kk) {
        const u32x4 r0 = *(const u32x4*)(raw + (i + kk) * 384 + part * 128 + sg * 16);
        const u32x4 r1 = *(const u32x4*)(raw + (i + kk) * 384 + part * 128 + sg * 16 + 8);
        const float* cwp = cwL + kk * 384 + part * 128 + sg * 16;
#pragma unroll
        for (int m = 0; m < 4; ++m) {
          const f32x4 w4 = *(const f32x4*)(cwp + 4 * m);
          const unsigned lo = (m < 2) ? r0[2 * m] : r1[2 * m - 4];
          const unsigned hi = (m < 2) ? r0[2 * m + 1] : r1[2 * m - 3];
          y[4 * m + 0] += w4[0] * __uint_as_float(lo << 16);
          y[4 * m + 1] += w4[1] * __uint_as_float(lo & 0xffff0000u);
          y[4 * m + 2] += w4[2] * __uint_as_float(hi << 16);
          y[4 * m + 3] += w4[3] * __uint_as_float(hi & 0xffff0000u);
        }
      }
      float ss = 0.f;
#pragma unroll
      for (int d = 0; d < 16; ++d) { y[d] = siluf_(y[d]); ss += y[d] * y[d]; }
      if (part < 2) {
        ss += __shfl_xor(ss, 1, 64);
        ss += __shfl_xor(ss, 2, 64);
        ss += __shfl_xor(ss, 4, 64);
        float scl = rsqrtf(ss + 1e-6f);
        if (part == 0) scl *= 0.08838834764831845f;
        bf16_t* dst = (part == 0 ? qb : kb) + i * 136 + sg * 16;
#pragma unroll
        for (int d = 0; d < 16; d += 2) *(unsigned*)(dst + d) = pack2(y[d] * scl, y[d + 1] * scl);
      } else {
#pragma unroll
        for (int d = 0; d < 16; ++d) vf[i * 128 + sg * 16 + d] = y[d];
      }
    }
  }
  __syncthreads();
  {
    const int which = w >> 2, tm = (w >> 1) & 1, tn = w & 1;
    const int r = lane & 31, hh = lane >> 5;
    const bf16_t* Ap = which ? qb : kb;
    f32x16 acc;
#pragma unroll
    for (int q = 0; q < 16; ++q) acc[q] = 0.f;
#pragma unroll
    for (int ks = 0; ks < 8; ++ks) {
      bf16x8 a = *(const bf16x8*)(Ap + (tm * 32 + r) * 136 + ks * 16 + hh * 8);
      bf16x8 bb = *(const bf16x8*)(kb + (tn * 32 + r) * 136 + ks * 16 + hh * 8);
      acc = MFMA32(a, bb, acc);
    }
    float* dst = which ? QK : KK;
#pragma unroll
    for (int q = 0; q < 16; ++q) {
      const int row = tm * 32 + (q & 3) + 8 * (q >> 2) + 4 * hh;
      dst[row * 68 + tn * 32 + r] = acc[q];
    }
  }
  __syncthreads();
  const int cidF = chunk_id(0, b, h, lat ? 4 + c : c);
  const int cidB = chunk_id(1, b, h, lat ? 4 + (63 - c) : 3 - c);
  {
    bf16_t* AT = (bf16_t*)((unsigned char*)p.out + OUT_AT);
    bf16_t* QG = (bf16_t*)(p.ws + OFF_QG);
    bf16_t* KDT = (bf16_t*)(p.ws + OFF_KDT);
    float* EGL = (float*)(p.ws + OFF_EGL);
    for (int e = tid; e < 2 * 64 * 64; e += NT) {
      const int dir = e >> 12, i = (e >> 6) & 63, s = e & 63;
      const int ti = dir ? 63 - i : i, ts = dir ? 63 - s : s;
      Am[e] = (i > s) ? bet[dir * 64 + i] * KK[ti * 68 + ts] * __expf(gcs[dir * 64 + i] - gcs[dir * 64 + s]) : 0.f;
    }
#pragma unroll 1
    for (int t = 0; t < 2; ++t) {
      const int e = tid + t * NT;
      const int dir = e >> 9, i = (e >> 3) & 63, s8 = e & 7;
      const int ti = dir ? 63 - i : i;
      const float gi = gcs[dir * 64 + i];
      float v[8];
#pragma unroll
      for (int k = 0; k < 8; ++k) {
        const int s = s8 * 8 + k;
        const int ts = dir ? 63 - s : s;
        v[k] = (i >= s) ? QK[ti * 68 + ts] * __expf(gi - gcs[dir * 64 + s]) : 0.f;
      }
      u32x4 o;
#pragma unroll
      for (int k = 0; k < 4; ++k) o[k] = pack2(v[2 * k], v[2 * k + 1]);
      *(u32x4*)(AT + (size_t)(dir ? cidB : cidF) * 4096 + i * 64 + s8 * 8) = o;
    }
#pragma unroll 1
    for (int t = 0; t < 4; ++t) {
      const int e = tid + t * NT;
      const int dir = e >> 10, i = (e >> 4) & 63, d8 = e & 15;
      const int ti = dir ? 63 - i : i;
      const float eg = __expf(gcs[dir * 64 + i]);
      const u32x4 qv = *(const u32x4*)(qb + ti * 136 + d8 * 8);
      u32x4 o;
#pragma unroll
      for (int k = 0; k < 4; ++k) o[k] = pack2(__uint_as_float(qv[k] << 16) * eg, __uint_as_float(qv[k] & 0xffff0000u) * eg);
      *(u32x4*)(QG + (size_t)(dir ? cidB : cidF) * 8192 + i * 128 + d8 * 8) = o;
    }
#pragma unroll 1
    for (int t = 0; t < 4; ++t) {
      const int e = tid + t * NT;
      const int dir = e >> 10, i8 = (e >> 7) & 7, d = e & 127;
      const float gl = gcs[dir * 64 + 63];
      float v[8];
#pragma unroll
      for (int k = 0; k < 8; ++k) {
        const int i = i8 * 8 + k;
        const int ti = dir ? 63 - i : i;
        v[k] = bf2f(kb[ti * 136 + d]) * __expf(gl - gcs[dir * 64 + i]);
      }
      u32x4 o;
#pragma unroll
      for (int k = 0; k < 4; ++k) o[k] = pack2(v[2 * k], v[2 * k + 1]);
      *(u32x4*)(KDT + (size_t)(dir ? cidB : cidF) * 8192 + d * 64 + i8 * 8) = o;
    }
    if (tid < 2) EGL[tid ? cidB : cidF] = __expf(gcs[tid * 64 + 63]);
  }
  __syncthreads();
  if (next_item < 2176) prepass_preload(p, next_item, pr, pf);
  {
    const int dir = tid >> 8, cidx = tid & 255;
    lds_b* sdst = (lds_b*)((bf16_t*)smem + (dir * 64) * 256 + cidx);
    if (dir == 0) {
      if (cidx < 128) solve_col<0, 0>((lds_cf*)Am, (lds_cf*)(vf + cidx), (lds_cb*)kb, (lds_cf*)bet, sdst);
      else solve_col<0, 1>((lds_cf*)Am, (lds_cf*)vf, (lds_cb*)(kb + (cidx - 128)), (lds_cf*)beg, sdst);
    } else {
      if (cidx < 128) solve_col<1, 0>((lds_cf*)(Am + 4096), (lds_cf*)(vf + cidx), (lds_cb*)kb, (lds_cf*)(bet + 64), sdst);
      else solve_col<1, 1>((lds_cf*)(Am + 4096), (lds_cf*)vf, (lds_cb*)(kb + (cidx - 128)), (lds_cf*)(beg + 64), sdst);
    }
  }
  __syncthreads();
  {
    bf16_t* WVg = (bf16_t*)((unsigned char*)p.out + OUT_WV);
    bf16_t* KCg = (bf16_t*)(p.ws + OFF_KC);
    const bf16_t* solL = (const bf16_t*)smem;
#pragma unroll 1
    for (int t = 0; t < 8; ++t) {
      const int e = tid + t * NT;
      const int dir = e >> 11, i = (e >> 5) & 63, sg = e & 31;
      const u32x4 v = *(const u32x4*)(solL + (dir * 64 + i) * 256 + sg * 8);
      bf16_t* dstp = (sg < 16) ? WVg + (size_t)(dir ? cidB : cidF) * 8192 + i * 128 + sg * 8
                               : KCg + (size_t)(dir ? cidB : cidF) * 8192 + i * 128 + (sg - 16) * 8;
      *(u32x4*)dstp = v;
    }
  }
  __syncthreads();
}

__device__ void gdn_seq_item(const Params& p, int item, unsigned char* smem) {
  const int tid = threadIdx.x, lane = tid & 63, w = tid >> 6;
  const int dvh = item & 1, h = (item >> 1) & 3, b = (item >> 3) & 7, dir = item >> 6;
  const bf16_t* KC = (const bf16_t*)(p.ws + OFF_KC);
  const bf16_t* QG = (const bf16_t*)(p.ws + OFF_QG);
  const bf16_t* KDT = (const bf16_t*)(p.ws + OFF_KDT);
  const bf16_t* WV = (const bf16_t*)((unsigned char*)p.out + OUT_WV);
  const bf16_t* AT = (const bf16_t*)((unsigned char*)p.out + OUT_AT);
  const float* EGL = (const float*)(p.ws + OFF_EGL);
  bf16_t* Odir = (bf16_t*)(p.ws + OFF_PQKV) + (size_t)dir * RLAT * 512;

  bf16_t* KCs = (bf16_t*)smem;
  bf16_t* QGs = KCs + 64 * 136;
  bf16_t* St = QGs + 64 * 136;
  bf16_t* ATs = St + 64 * 136;
  bf16_t* VnT = ATs + 64 * 72;
  bf16_t* WVs = VnT + 64 * 72;
  bf16_t* KDTs = WVs + 64 * 72;

  const int dkt = w >> 1, dvt = w & 1;
  const int r32 = lane & 31, h32 = lane >> 5;
  const int l15 = lane & 15, q4 = lane >> 4;
  const int tm = w >> 1, tn0 = (w & 1) * 2;
  f32x16 S;
#pragma unroll
  for (int q = 0; q < 16; ++q) S[q] = 0.f;
  for (int i = tid; i < 64 * 136 / 2; i += NT) ((unsigned*)St)[i] = 0u;

  const int cid0 = chunk_id(dir, b, h, 0);
  u32x4 rA[8], rB[8];
  float eglA, eglB;
#define SEQ_LOAD(R, EG, cid_)                                                                 \
  {                                                                                           \
    const size_t base_ = (size_t)(cid_) * 8192;                                               \
    R[0] = *(const u32x4*)(KC + base_ + tid * 8);                                             \
    R[1] = *(const u32x4*)(KC + base_ + (tid + 512) * 8);                                     \
    R[2] = *(const u32x4*)(QG + base_ + tid * 8);                                             \
    R[3] = *(const u32x4*)(QG + base_ + (tid + 512) * 8);                                     \
    R[4] = *(const u32x4*)(KDT + base_ + tid * 8);                                            \
    R[5] = *(const u32x4*)(KDT + base_ + (tid + 512) * 8);                                    \
    R[6] = *(const u32x4*)(AT + (size_t)(cid_) * 4096 + tid * 8);                             \
    R[7] = *(const u32x4*)(WV + base_ + (tid >> 3) * 128 + dvh * 64 + (tid & 7) * 8);        \
    EG = EGL[cid_];                                                                           \
  }
#define SEQ_STORE(R)                                                       \
  {                                                                        \
    *(u32x4*)(KCs + (tid >> 4) * 136 + (tid & 15) * 8) = R[0];             \
    *(u32x4*)(KCs + ((tid + 512) >> 4) * 136 + (tid & 15) * 8) = R[1];     \
    *(u32x4*)(QGs + (tid >> 4) * 136 + (tid & 15) * 8) = R[2];             \
    *(u32x4*)(QGs + ((tid + 512) >> 4) * 136 + (tid & 15) * 8) = R[3];     \
    *(u32x4*)(KDTs + (tid >> 3) * 72 + (tid & 7) * 8) = R[4];              \
    *(u32x4*)(KDTs + ((tid + 512) >> 3) * 72 + (tid & 7) * 8) = R[5];      \
    *(u32x4*)(ATs + (tid >> 3) * 72 + (tid & 7) * 8) = R[6];               \
    *(u32x4*)(WVs + (tid >> 3) * 72 + (tid & 7) * 8) = R[7];               \
  }
  auto compute = [&](const int ci, const float egl) __attribute__((always_inline)) {
    f32x4 accO[2];
#pragma unroll
    for (int t = 0; t < 2; ++t) {
      const int tn = tn0 + t;
      f32x4 accV = {0.f, 0.f, 0.f, 0.f};
      accO[t] = accV;
#pragma unroll
      for (int ks = 0; ks < 4; ++ks) {
        bf16x8 aK = *(const bf16x8*)(KCs + (tm * 16 + l15) * 136 + ks * 32 + q4 * 8);
        bf16x8 aQ = *(const bf16x8*)(QGs + (tm * 16 + l15) * 136 + ks * 32 + q4 * 8);
        bf16x8 bS = *(const bf16x8*)(St + (tn * 16 + l15) * 136 + ks * 32 + q4 * 8);
        accV = MFMA16(aK, bS, accV);
        accO[t] = MFMA16(aQ, bS, accO[t]);
      }
      float vn[4];
#pragma unroll
      for (int q = 0; q < 4; ++q) vn[q] = bf2f(WVs[(tm * 16 + q4 * 4 + q) * 72 + tn * 16 + l15]) - accV[q];
      uint2 pk;
      pk.x = pack2(vn[0], vn[1]);
      pk.y = pack2(vn[2], vn[3]);
      *(uint2*)(VnT + (tn * 16 + l15) * 72 + tm * 16 + q4 * 4) = pk;
    }
    __syncthreads();
#pragma unroll
    for (int t = 0; t < 2; ++t) {
      const int tn = tn0 + t;
#pragma unroll
      for (int ks = 0; ks < 2; ++ks) {
        bf16x8 aA = *(const bf16x8*)(ATs + (tm * 16 + l15) * 72 + ks * 32 + q4 * 8);
        bf16x8 bV = *(const bf16x8*)(VnT + (tn * 16 + l15) * 72 + ks * 32 + q4 * 8);
        accO[t] = MFMA16(aA, bV, accO[t]);
      }
      if (ci >= 4) {
#pragma unroll
        for (int q = 0; q < 4; ++q) {
          const int i = tm * 16 + q4 * 4 + q;
          const int sp = (ci - 4) * 64 + i;
          const int j = dir ? 4095 - sp : sp;
          const int t_r = (j & 63) * 64 + (j >> 6);
          Odir[((size_t)b * 4096 + t_r) * 512 + h * 128 + dvh * 64 + tn * 16 + l15] = f2bf(accO[t][q]);
        }
      }
    }
#pragma unroll
    for (int q = 0; q < 16; ++q) S[q] *= egl;
#pragma unroll
    for (int ks = 0; ks < 4; ++ks) {
      bf16x8 a = *(const bf16x8*)(KDTs + (dkt * 32 + r32) * 72 + ks * 16 + h32 * 8);
      bf16x8 bb = *(const bf16x8*)(VnT + (dvt * 32 + r32) * 72 + ks * 16 + h32 * 8);
      S = MFMA32(a, bb, S);
    }
#pragma unroll
    for (int g = 0; g < 4; ++g) {
      uint2 pk;
      pk.x = pack2(S[4 * g + 0], S[4 * g + 1]);
      pk.y = pack2(S[4 * g + 2], S[4 * g + 3]);
      *(uint2*)(St + (dvt * 32 + r32) * 136 + dkt * 32 + 8 * g + 4 * h32) = pk;
    }
    __syncthreads();
  };
  SEQ_LOAD(rA, eglA, cid0)
  SEQ_LOAD(rB, eglB, cid0 + 1)
  for (int ci = 0; ci < 68; ci += 2) {
    SEQ_STORE(rA)
    const float e0 = eglA;
    __syncthreads();
    if (ci + 2 < 68) SEQ_LOAD(rA, eglA, cid0 + ci + 2)
    compute(ci, e0);
    SEQ_STORE(rB)
    const float e1 = eglB;
    __syncthreads();
    if (ci + 3 < 68) SEQ_LOAD(rB, eglB, cid0 + ci + 3)
    compute(ci + 1, e1);
  }
#undef SEQ_LOAD
#undef SEQ_STORE
}

__device__ __forceinline__ float neg_expm1(float y) {
  return (y > -0.02f) ? -(y + 0.5f * y * y + (1.f / 6.f) * y * y * y) : 1.f - __expf(y);
}
__device__ void rglru_item(const Params& p, int it, unsigned char* smem) {
  const int tid = threadIdx.x, lane = tid & 63, w = tid >> 6;
  const int n = it & 7, b = (it >> 3) & 7, dir = it >> 6;
  const bf16_t* PRG = (const bf16_t*)(p.ws + OFF_PRG);
  bf16_t* Hdir = (bf16_t*)(p.ws + OFF_H) + (size_t)dir * RLAT * 512;
  bf16_t* ur = (bf16_t*)smem;
  bf16_t* xcb = ur + 132 * 72;
  bf16_t* wgt = xcb + 128 * 72;
  float* aL = (float*)(smem + (132 + 128 + 128) * 72 * 2);
  float* bL = aL + 128 * 64;
  float* segA = bL + 128 * 64;
  float* segB = segA + 512;
  for (int i = tid; i < 2 * 64 * 64; i += NT) {
    const int g = i >> 12, d = (i >> 6) & 63, e = i & 63;
    wgt[(g * 64 + e) * 72 + d] = f2bf(p.rg_gate_w[((((size_t)dir * 2 + g) * 8 + n) * 64 + d) * 64 + e]);
  }
  float* cwL = segB + 512;
  if (tid < 320) {
    const int kk = tid >> 6, e = tid & 63;
    cwL[tid] = (kk < 4) ? p.rg_conv_w[kk * 512 + n * 64 + e] : p.rg_conv_b[n * 64 + e];
  }
  const int cseg = tid & 7;
  const int tt = w >> 1, et = w & 1, r32 = lane & 31, h32 = lane >> 5;
  const int eg = et * 32 + r32;
  const float bias_r = p.rg_gate_b[(dir * 2 + 0) * 512 + n * 64 + eg];
  const float bias_i = p.rg_gate_b[(dir * 2 + 1) * 512 + n * 64 + eg];
  const float sp8 = -8.f * softplusf_(-p.rg_lambda[dir * 512 + n * 64 + eg]);
  float hstate = 0.f;
  u32x4 pu0, pu1, pu2;
#define RG_LOAD(tile_)                                                                           \
  {                                                                                              \
    const bool lat_ = (tile_) >= 2;                                                              \
    const int tl_ = lat_ ? (tile_) - 2 : (tile_);                                                \
    const int ntl_ = lat_ ? 32 : 2;                                                              \
    const int t0_ = (dir ? (ntl_ - 1 - tl_) : tl_) * 128;                                        \
    const int Tseq_ = lat_ ? 4096 : 256;                                                         \
    const size_t rbase_ = lat_ ? (size_t)b * 4096 : (size_t)RLAT + b * 256;                      \
    const u32x4 z_ = {0u, 0u, 0u, 0u};                                                           \
    { const int s_ = tid; const int t_ = t0_ - 2 + (s_ >> 3);                                   \
      pu0 = (t_ >= 0 && t_ < Tseq_) ? *(const u32x4*)(PRG + (rbase_ + t_) * 1024 + n * 64 + (s_ & 7) * 8) : z_; } \
    { const int s_ = tid + 512; const int t_ = t0_ - 2 + (s_ >> 3);                             \
      pu1 = (t_ >= 0 && t_ < Tseq_) ? *(const u32x4*)(PRG + (rbase_ + t_) * 1024 + n * 64 + (s_ & 7) * 8) : z_; } \
    { const int s_ = tid + 1024; const int t_ = t0_ - 2 + (s_ >> 3);                            \
      pu2 = (s_ < 1048 && t_ >= 0 && t_ < Tseq_) ? *(const u32x4*)(PRG + (rbase_ + t_) * 1024 + n * 64 + (s_ & 7) * 8) : z_; } \
  }
  RG_LOAD(0)
  for (int tile = 0; tile < 34; ++tile) {
    const bool lat = tile >= 2;
    const int tl = lat ? tile - 2 : tile;
    const int ntl = lat ? 32 : 2;
    const int t0 = (dir ? (ntl - 1 - tl) : tl) * 128;
    *(u32x4*)(ur + (tid >> 3) * 72 + (tid & 7) * 8) = pu0;
    *(u32x4*)(ur + ((tid + 512) >> 3) * 72 + (tid & 7) * 8) = pu1;
    if (tid + 1024 < 1048) *(u32x4*)(ur + ((tid + 1024) >> 3) * 72 + (tid & 7) * 8) = pu2;
    __syncthreads();
    if (tile + 1 < 34) RG_LOAD(tile + 1)
#pragma unroll
    for (int half = 0; half < 2; ++half) {
      const int tok = (tid >> 3) + half * 64;
      float a[8];
      {
        const f32x4 c0 = *(const f32x4*)(cwL + 256 + cseg * 8), c1 = *(const f32x4*)(cwL + 256 + cseg * 8 + 4);
#pragma unroll
        for (int j = 0; j < 4; ++j) { a[j] = c0[j]; a[4 + j] = c1[j]; }
      }
#pragma unroll
      for (int kk = 0; kk < 4; ++kk) {
        const u32x4 uv = *(const u32x4*)(ur + (tok + kk) * 72 + cseg * 8);
        const f32x4 w0 = *(const f32x4*)(cwL + kk * 64 + cseg * 8), w1 = *(const f32x4*)(cwL + kk * 64 + cseg * 8 + 4);
        a[0] += w0[0] * __uint_as_float(uv[0] << 16);
        a[1] += w0[1] * __uint_as_float(uv[0] & 0xffff0000u);
        a[2] += w0[2] * __uint_as_float(uv[1] << 16);
        a[3] += w0[3] * __uint_as_float(uv[1] & 0xffff0000u);
        a[4] += w1[0] * __uint_as_float(uv[2] << 16);
        a[5] += w1[1] * __uint_as_float(uv[2] & 0xffff0000u);
        a[6] += w1[2] * __uint_as_float(uv[3] << 16);
        a[7] += w1[3] * __uint_as_float(uv[3] & 0xffff0000u);
      }
      u32x4 o;
#pragma unroll
      for (int m = 0; m < 4; ++m) o[m] = pack2(a[2 * m], a[2 * m + 1]);
      *(u32x4*)(xcb + tok * 72 + cseg * 8) = o;
    }
    __syncthreads();
    {
      f32x16 accR, accI;
#pragma unroll
      for (int q = 0; q < 16; ++q) { accR[q] = 0.f; accI[q] = 0.f; }
#pragma unroll
      for (int ks = 0; ks < 4; ++ks) {
        bf16x8 a = *(const bf16x8*)(xcb + (tt * 32 + r32) * 72 + ks * 16 + h32 * 8);
        bf16x8 br = *(const bf16x8*)(wgt + (et * 32 + r32) * 72 + ks * 16 + h32 * 8);
        bf16x8 bi = *(const bf16x8*)(wgt + (64 + et * 32 + r32) * 72 + ks * 16 + h32 * 8);
        accR = MFMA32(a, br, accR);
        accI = MFMA32(a, bi, accI);
      }
#pragma unroll
      for (int q = 0; q < 16; ++q) {
        const int tok = tt * 32 + (q & 3) + 8 * (q >> 2) + 4 * h32;
        const float er = __expf(-(accR[q] + bias_r)), ei = __expf(-(accI[q] + bias_i));
        const float dr = 1.f + er, di = 1.f + ei;
        const float inv = __frcp_rn(dr * di);
        const float rr = inv * di, ii = inv * dr;
        const float log_a = sp8 * rr;
        const float av = __expf(log_a);
        const float y = -2.f * log_a;
        const float om = (y < 0.04f) ? y * (1.f - y * (0.5f - y * (1.f / 6.f - y * (1.f / 24.f)))) : 1.f - av * av;
        const float xv = bf2f(xcb[tok * 72 + eg]);
        aL[tok * 64 + eg] = av;
        bL[tok * 64 + eg] = __builtin_amdgcn_sqrtf(om) * (ii * xv);
      }
    }
    __syncthreads();
    float Pk[16], Hk[16];
    {
      float P = 1.f, hl = 0.f;
#pragma unroll
      for (int k = 0; k < 16; ++k) {
        const int s = 16 * w + k;
        const int tok = dir ? 127 - s : s;
        const float av = aL[tok * 64 + lane], bv = bL[tok * 64 + lane];
        hl = av * hl + bv;
        P = P * av;
        Pk[k] = P;
        Hk[k] = hl;
      }
      segA[w * 64 + lane] = P;
      segB[w * 64 + lane] = hl;
    }
    __syncthreads();
    {
      float hin = hstate, my_in = 0.f;
#pragma unroll
      for (int ww = 0; ww < 8; ++ww) {
        if (ww == w) my_in = hin;
        hin = segA[ww * 64 + lane] * hin + segB[ww * 64 + lane];
      }
      hstate = hin;
      if (lat) {
#pragma unroll
        for (int k = 0; k < 16; ++k) {
          const int s = 16 * w + k;
          const int tok = dir ? 127 - s : s;
          Hdir[((size_t)b * 4096 + t0 + tok) * 512 + n * 64 + lane] = f2bf(Pk[k] * my_in + Hk[k]);
        }
      }
    }
  }
  __syncthreads();
#undef RG_LOAD
}

__device__ void phase_ya(const Params& p) {
  const int lane = threadIdx.x & 63, w = threadIdx.x >> 6;
  const bf16_t* PRG = (const bf16_t*)(p.ws + OFF_PRG);
  const bf16_t* PZ = (const bf16_t*)(p.ws + OFF_PZ);
  const bf16_t* HF = (const bf16_t*)(p.ws + OFF_H);
  const bf16_t* HB = HF + (size_t)RLAT * 512;
  const bf16_t* OF = (const bf16_t*)(p.ws + OFF_PQKV);
  const bf16_t* OB = OF + (size_t)RLAT * 512;
  bf16_t* YA = (bf16_t*)(p.ws + OFF_QG);
  for (int row = blockIdx.x * 8 + w; row < RLAT; row += gridDim.x * 8) {
    const int c0 = lane * 8;
    uint4 hf = *(const uint4*)(HF + (size_t)row * 512 + c0);
    uint4 hb = *(const uint4*)(HB + (size_t)row * 512 + c0);
    uint4 gt = *(const uint4*)(PRG + (size_t)row * 1024 + 512 + c0);
    uint4 of = *(const uint4*)(OF + (size_t)row * 512 + c0);
    uint4 ob = *(const uint4*)(OB + (size_t)row * 512 + c0);
    uint4 zz = *(const uint4*)(PZ + (size_t)row * 512 + c0);
    const unsigned* hfp = (const unsigned*)&hf; const unsigned* hbp = (const unsigned*)&hb;
    const unsigned* gtp = (const unsigned*)&gt; const unsigned* ofp = (const unsigned*)&of;
    const unsigned* obp = (const unsigned*)&ob; const unsigned* zzp = (const unsigned*)&zz;
    float y[8], o[8], z[8];
    float ss = 0.f;
#pragma unroll
    for (int q = 0; q < 4; ++q) {
      float hf0 = bf2f((bf16_t)(hfp[q] & 0xffff)), hf1 = bf2f((bf16_t)(hfp[q] >> 16));
      float hb0 = bf2f((bf16_t)(hbp[q] & 0xffff)), hb1 = bf2f((bf16_t)(hbp[q] >> 16));
      float g0 = bf2f((bf16_t)(gtp[q] & 0xffff)), g1 = bf2f((bf16_t)(gtp[q] >> 16));
      y[2 * q] = (hf0 + hb0) * gelu_tanh(g0);
      y[2 * q + 1] = (hf1 + hb1) * gelu_tanh(g1);
      o[2 * q] = bf2f((bf16_t)(ofp[q] & 0xffff)) + bf2f((bf16_t)(obp[q] & 0xffff));
      o[2 * q + 1] = bf2f((bf16_t)(ofp[q] >> 16)) + bf2f((bf16_t)(obp[q] >> 16));
      z[2 * q] = bf2f((bf16_t)(zzp[q] & 0xffff));
      z[2 * q + 1] = bf2f((bf16_t)(zzp[q] >> 16));
      ss += o[2 * q] * o[2 * q] + o[2 * q + 1] * o[2 * q + 1];
    }
    ss += __shfl_xor(ss, 1, 64);
    ss += __shfl_xor(ss, 2, 64);
    ss += __shfl_xor(ss, 4, 64);
    ss += __shfl_xor(ss, 8, 64);
    const float rstd = rsqrtf(ss * (1.f / 128.f) + 1e-6f);
    const int d0 = (lane & 15) * 8;
    uint4 o1, o2;
    unsigned* o1p = (unsigned*)&o1; unsigned* o2p = (unsigned*)&o2;
#pragma unroll
    for (int q = 0; q < 4; ++q) {
      o1p[q] = pack2(y[2 * q], y[2 * q + 1]);
      float a0 = o[2 * q] * rstd * p.gdn_norm_g[d0 + 2 * q] * siluf_(z[2 * q]);
      float a1 = o[2 * q + 1] * rstd * p.gdn_norm_g[d0 + 2 * q + 1] * siluf_(z[2 * q + 1]);
      o2p[q] = pack2(a0, a1);
    }
    *(uint4*)(YA + (size_t)row * 1024 + c0) = o1;
    *(uint4*)(YA + (size_t)row * 1024 + 512 + c0) = o2;
  }
}

__device__ void phase_outproj(const Params& p, unsigned char* smem) {
  const bf16_t* YA = (const bf16_t*)(p.ws + OFF_QG);
  const bf16_t* WT = (const bf16_t*)(p.ws + OFF_WOUT);
  const float* mod = (const float*)(p.ws + OFF_MOD);
  const int lane = threadIdx.x & 63, w = threadIdx.x >> 6;
  const int wm = w >> 2, wn = w & 3, r = lane & 31, h = lane >> 5;
  const bool swz = (gridDim.x == 256);
  const int xcd = blockIdx.x & 7;
  const int ntiles = swz ? 16 * 4 : 128 * 4;
  for (int k = swz ? (blockIdx.x >> 3) : blockIdx.x; k < ntiles; k += swz ? 32 : gridDim.x) {
    const int mt = swz ? xcd + 8 * (k >> 2) : (k >> 2), nt = k & 3;
    const int m0 = mt * 256, n0 = nt * 256;
    f32x16 acc[4][2];
    gemm_tile256(YA + (size_t)m0 * 1024, WT + (size_t)n0 * 1024, acc, smem);
    const int bb = m0 >> 12;
    float* Cf = (float*)(smem + w * 8704);
#pragma unroll
    for (int i = 0; i < 4; ++i) {
#pragma unroll
      for (int j = 0; j < 2; ++j)
#pragma unroll
        for (int q = 0; q < 16; ++q) Cf[((q & 3) + 8 * (q >> 2) + 4 * h) * 68 + j * 32 + r] = acc[i][j][q];
#pragma unroll
      for (int it = 0; it < 8; ++it) {
        const int row = (lane >> 4) + 4 * it, seg = lane & 15;
        const f32x4 av = *(const f32x4*)(Cf + row * 68 + seg * 4);
        const size_t grow = m0 + wm * 128 + i * 32 + row;
        const int n = n0 + wn * 64 + seg * 4;
        const f32x4 xv = *(const f32x4*)(p.x + grow * 1024 + n);
        const f32x4 gv = *(const f32x4*)(mod + bb * 6144 + 2048 + n);
        f32x4 o;
        o[0] = xv[0] + gv[0] * av[0]; o[1] = xv[1] + gv[1] * av[1]; o[2] = xv[2] + gv[2] * av[2]; o[3] = xv[3] + gv[3] * av[3];
        *(f32x4*)(p.out + grow * 1024 + n) = o;
      }
    }
  }
}

#define INS16(list, val)                       \
  {                                            \
    float nv_ = (val);                         \
    _Pragma("unroll") for (int k_ = 0; k_ < 16; ++k_) { \
      float hi_ = fmaxf(list[k_], nv_);        \
      nv_ = fminf(list[k_], nv_);              \
      list[k_] = hi_;                          \
    }                                          \
  }

__device__ __forceinline__ void cswap_desc(float& a, float& b) {
  const float hi = fmaxf(a, b), lo = fminf(a, b);
  a = hi;
  b = lo;
}
__device__ __forceinline__ void bitonic_sort16_desc(float (&a)[16]) {
#pragma unroll
  for (int k = 2; k <= 16; k <<= 1)
#pragma unroll
    for (int j = k >> 1; j > 0; j >>= 1)
#pragma unroll
      for (int i = 0; i < 16; ++i) {
        const int l = i ^ j;
        if (l > i) {
          if ((i & k) == 0) cswap_desc(a[i], a[l]);
          else cswap_desc(a[l], a[i]);
        }
      }
}
__device__ __forceinline__ void merge_top16_desc(float (&a)[16], const float (&b)[16]) {
#pragma unroll
  for (int i = 0; i < 16; ++i) a[i] = fmaxf(a[i], b[15 - i]);
#pragma unroll
  for (int j = 8; j > 0; j >>= 1)
#pragma unroll
    for (int i = 0; i < 16; ++i) {
      const int l = i ^ j;
      if (l > i) cswap_desc(a[i], a[l]);
    }
}

__device__ void phase_peer_query(const Params& p, unsigned char* smem) {
  const bf16_t* H2 = (const bf16_t*)(p.ws + OFF_PRG);
  const bf16_t* WT = (const bf16_t*)(p.ws + OFF_WQ);
  const bf16_t* KEYS = (const bf16_t*)(p.ws + OFF_KEYS);
  float* LISTS = (float*)(p.ws + OFF_PZ);
  bf16_t* Qs = (bf16_t*)smem;
  bf16_t* Ks = (bf16_t*)(smem + 69632);
  const int tid = threadIdx.x, lane = tid & 63, w = tid >> 6;
  const int wm = w >> 1, wn = w & 1, r = lane & 31, h = lane >> 5;
  const bool swz = (gridDim.x == 256);
  const int xcd = blockIdx.x & 7;
  const int ntiles = swz ? 16 * 16 : 128 * 16;
  for (int k = swz ? (blockIdx.x >> 3) : blockIdx.x; k < ntiles; k += swz ? 32 : gridDim.x) {
    int mt, hx;
    if (!swz) { mt = k >> 4; hx = k & 15; }
    else { const int g = k >> 7, kk = k & 127; mt = xcd + 8 * (kk >> 3); hx = g * 8 + (kk & 7); }
    const int m0 = mt * 256, n0 = hx * 128;
    const int xh = hx & 1;
    f32x16 acc[2][2];
    gemm_tile(H2 + (size_t)m0 * 1024, WT + (size_t)n0 * 1024, acc, smem);
#pragma unroll
    for (int i = 0; i < 2; ++i)
#pragma unroll
      for (int j = 0; j < 2; ++j)
#pragma unroll
        for (int q = 0; q < 16; ++q) {
          const int row = wm * 64 + i * 32 + (q & 3) + 8 * (q >> 2) + 4 * h;
          const int col = wn * 64 + j * 32 + r;
          Qs[row * 136 + col] = f2bf(acc[i][j][q]);
        }
#pragma unroll
    for (int i = 0; i < 4; ++i) {
      int seg = tid + 512 * i;
      *(uint4*)(Ks + (seg >> 4) * 136 + (seg & 15) * 8) = *(const uint4*)(KEYS + (size_t)xh * 16384 + seg * 8);
    }
    __syncthreads();
    f32x16 sc[4];
#pragma unroll
    for (int m4 = 0; m4 < 4; ++m4)
#pragma unroll
      for (int q = 0; q < 16; ++q) sc[m4][q] = 0.f;
#pragma unroll
    for (int ks = 0; ks < 8; ++ks) {
      bf16x8 bq = *(const bf16x8*)(Qs + (w * 32 + r) * 136 + ks * 16 + h * 8);
#pragma unroll
      for (int m4 = 0; m4 < 4; ++m4) {
        bf16x8 ak = *(const bf16x8*)(Ks + (m4 * 32 + r) * 136 + ks * 16 + h * 8);
        sc[m4] = MFMA32(ak, bq, sc[m4]);
      }
    }
    float list[16];
#pragma unroll
    for (int m4 = 0; m4 < 4; ++m4) {
      float t[16];
#pragma unroll
      for (int q = 0; q < 16; ++q) {
        const unsigned kidx = (unsigned)(m4 * 32 + (q & 3) + 8 * (q >> 2)) | ((unsigned)h << 2);
        t[q] = __uint_as_float((__float_as_uint(sc[m4][q]) & ~127u) | kidx);
      }
      bitonic_sort16_desc(t);
      if (m4 == 0) {
#pragma unroll
        for (int q = 0; q < 16; ++q) list[q] = t[q];
      } else {
        merge_top16_desc(list, t);
      }
    }
    {
      float other[16];
#pragma unroll
      for (int k = 0; k < 16; ++k) other[k] = __shfl_xor(list[k], 32, 64);
      merge_top16_desc(list, other);
    }
    if (h == 0) {
      const size_t tok = (size_t)m0 + w * 32 + r;
      float4* dst = (float4*)(LISTS + (tok * 16 + hx) * 16);
#pragma unroll
      for (int k = 0; k < 4; ++k) dst[k] = make_float4(list[4 * k], list[4 * k + 1], list[4 * k + 2], list[4 * k + 3]);
    }
    __syncthreads();
  }
}

constexpr size_t OFF_UQ = OFF_KDT;
constexpr size_t OFF_VQ = OFF_KDT + 16777216;
constexpr size_t OFF_SUV = OFF_KC;
constexpr size_t OFF_PD = OFF_KC + 1048576;
constexpr size_t OFF_SELE = OFF_PQKV;
constexpr size_t OFF_SELG = OFF_PQKV + 16777216;
constexpr size_t OFF_HQ = OFF_PQKV + 33554432;
constexpr size_t OFF_HSC = OFF_PQKV + 67108864;
constexpr size_t OFF_CQ = OFF_PQKV + 68157440;
constexpr size_t OFF_CSC = OFF_PQKV + 72351744;
constexpr size_t OFF_SS = OFF_PQKV + 73400320;
__device__ void phase_quant_uv(const Params& p) {
  const int lane = threadIdx.x & 63, w = threadIdx.x >> 6;
  float* SC = (float*)(p.ws + OFF_SUV);
  for (int row = blockIdx.x * 8 + w; row < 32768; row += gridDim.x * 8) {
    const float* src = (row < 16384 ? p.peer_u : p.peer_v) + (size_t)(row & 16383) * 1024 + lane * 16;
    float4 v[4];
    float am = 0.f;
#pragma unroll
    for (int m = 0; m < 4; ++m) {
      v[m] = ((const float4*)src)[m];
      am = fmaxf(am, fmaxf(fmaxf(fabsf(v[m].x), fabsf(v[m].y)), fmaxf(fabsf(v[m].z), fabsf(v[m].w))));
    }
#pragma unroll
    for (int o = 32; o > 0; o >>= 1) am = fmaxf(am, __shfl_xor(am, o, 64));
    am = fmaxf(am, 1e-30f);
    const float inv = 127.f / am;
    u32x4 pk;
#pragma unroll
    for (int m = 0; m < 4; ++m) {
      const unsigned q0 = (unsigned)((int)rintf(v[m].x * inv)) & 255u;
      const unsigned q1 = (unsigned)((int)rintf(v[m].y * inv)) & 255u;
      const unsigned q2 = (unsigned)((int)rintf(v[m].z * inv)) & 255u;
      const unsigned q3 = (unsigned)((int)rintf(v[m].w * inv)) & 255u;
      pk[m] = q0 | (q1 << 8) | (q2 << 16) | (q3 << 24);
    }
    unsigned char* base = p.ws + (row < 16384 ? OFF_UQ : OFF_VQ);
    *(u32x4*)(base + (size_t)(lane >> 3) * 2097152 + (size_t)(row & 16383) * 128 + (lane & 7) * 16) = pk;
    if (lane == 0) SC[row] = am * (1.f / 127.f);
  }
}

__device__ void phase_peer_select(const Params& p, unsigned char* smem) {
  const int tid = threadIdx.x, lane = tid & 63, w = tid >> 6;
  const float* LISTS = (const float*)(p.ws + OFF_PZ);
  unsigned short* SELE = (unsigned short*)(p.ws + OFF_SELE);
  float* SELG = (float*)(p.ws + OFF_SELG);
  int* tab = (int*)smem + tid * 33;
  for (int base = (blockIdx.x * 8 + w) * 8; base < RLAT; base += gridDim.x * 64) {
    const int tok = base + (lane >> 3), hh = lane & 7;
    float s1[16], s2[16];
    const float4* l1 = (const float4*)(LISTS + ((size_t)tok * 16 + hh * 2) * 16);
#pragma unroll
    for (int k = 0; k < 4; ++k) {
      float4 a = l1[k], c2 = l1[4 + k];
      s1[4 * k] = a.x; s1[4 * k + 1] = a.y; s1[4 * k + 2] = a.z; s1[4 * k + 3] = a.w;
      s2[4 * k] = c2.x; s2[4 * k + 1] = c2.y; s2[4 * k + 2] = c2.z; s2[4 * k + 3] = c2.w;
    }
#pragma unroll
    for (int k = 0; k < 16; ++k) {
      tab[k] = (int)(__float_as_uint(s1[k]) & 127u);
      tab[16 + k] = (int)(__float_as_uint(s2[k]) & 127u);
      s1[k] = __uint_as_float(__float_as_uint(s1[k]) & ~127u);
      s2[k] = __uint_as_float(__float_as_uint(s2[k]) & ~127u);
    }
    float list[16];
#pragma unroll
    for (int k = 0; k < 16; ++k) list[k] = -3.0e38f;
#pragma unroll
    for (int i = 0; i < 16; ++i)
#pragma unroll
      for (int j = 0; j < 16; ++j)
        if ((i + 1) * (j + 1) <= 16) {
          const float cs = s1[i] + s2[j];
          const float v = __uint_as_float((__float_as_uint(cs) & ~255u) | (unsigned)(i * 16 + j));
          INS16(list, v);
        }
    float ex[16], sum = 0.f;
#pragma unroll
    for (int k = 0; k < 16; ++k) { ex[k] = __expf(list[k] - list[0]); sum += ex[k]; }
    const float inv = 1.f / sum;
#pragma unroll
    for (int k = 0; k < 16; ++k) {
      const unsigned bits = __float_as_uint(list[k]);
      const int i = (bits >> 4) & 15, j = bits & 15;
      const int idx = hh * 16 + k;
      const int pos = (idx & 7) * 16 + (idx >> 3);
      SELE[(size_t)tok * 128 + pos] = (unsigned short)(tab[i] * 128 + tab[16 + j]);
      SELG[(size_t)tok * 128 + pos] = ex[k] * inv;
    }
  }
  {
    const bf16_t* H2 = (const bf16_t*)(p.ws + OFF_PRG);
    float* HSC = (float*)(p.ws + OFF_HSC);
    for (int tok = blockIdx.x * 8 + w; tok < RLAT; tok += gridDim.x * 8) {
      const u32x4 a = *(const u32x4*)(H2 + (size_t)tok * 1024 + lane * 16);
      const u32x4 b = *(const u32x4*)(H2 + (size_t)tok * 1024 + lane * 16 + 8);
      float v[16];
#pragma unroll
      for (int m = 0; m < 4; ++m) {
        v[2 * m] = __uint_as_float(a[m] << 16); v[2 * m + 1] = __uint_as_float(a[m] & 0xffff0000u);
        v[8 + 2 * m] = __uint_as_float(b[m] << 16); v[8 + 2 * m + 1] = __uint_as_float(b[m] & 0xffff0000u);
      }
      float am = 0.f;
#pragma unroll
      for (int j = 0; j < 16; ++j) am = fmaxf(am, fabsf(v[j]));
#pragma unroll
      for (int o = 32; o > 0; o >>= 1) am = fmaxf(am, __shfl_xor(am, o, 64));
      am = fmaxf(am, 1e-30f);
      const float inv = 127.f / am;
      u32x4 pk;
#pragma unroll
      for (int m = 0; m < 4; ++m) {
        const unsigned q0 = (unsigned)((int)rintf(v[4 * m] * inv)) & 255u;
        const unsigned q1 = (unsigned)((int)rintf(v[4 * m + 1] * inv)) & 255u;
        const unsigned q2 = (unsigned)((int)rintf(v[4 * m + 2] * inv)) & 255u;
        const unsigned q3 = (unsigned)((int)rintf(v[4 * m + 3] * inv)) & 255u;
        pk[m] = q0 | (q1 << 8) | (q2 << 16) | (q3 << 24);
      }
      *(u32x4*)(p.ws + OFF_HQ + (size_t)tok * 1024 + lane * 16) = pk;
      if (lane == 0) HSC[tok] = am * (1.f / 127.f);
    }
  }
}

__device__ void phase_peer_udot(const Params& p) {
  const int lane = threadIdx.x & 63, w = threadIdx.x >> 6;
  const int g = lane >> 3, part = lane & 7;
  const unsigned short* SELE = (const unsigned short*)(p.ws + OFF_SELE);
  short* PD = (short*)(p.ws + OFF_PD);
  for (int item = blockIdx.x; item < 256; item += gridDim.x) {
    const int x = item & 7, lb = item >> 3;
    const unsigned char* US = p.ws + OFF_UQ + (size_t)x * 2097152 + part * 16;
    for (int t = 0; t < 128; ++t) {
      const int tok = lb * 1024 + w * 128 + t;
      const u32x4 hq = *(const u32x4*)(p.ws + OFF_HQ + (size_t)tok * 1024 + x * 128 + part * 16);
      int eid[16];
#pragma unroll
      for (int m = 0; m < 2; ++m) {
        const u32x4 e4 = *(const u32x4*)(SELE + (size_t)tok * 128 + g * 16 + m * 8);
#pragma unroll
        for (int q = 0; q < 4; ++q) { eid[8 * m + 2 * q] = (int)(e4[q] & 0xffffu); eid[8 * m + 2 * q + 1] = (int)(e4[q] >> 16); }
      }
      u32x4 uq[16];
#pragma unroll
      for (int it = 0; it < 16; ++it) uq[it] = *(const u32x4*)(US + (size_t)eid[it] * 128);
      int d0 = 0, d1 = 0;
#pragma unroll
      for (int it = 0; it < 16; ++it) {
        int d = __builtin_amdgcn_sdot4((int)uq[it][0], (int)hq[0], 0, false);
        d = __builtin_amdgcn_sdot4((int)uq[it][1], (int)hq[1], d, false);
        d = __builtin_amdgcn_sdot4((int)uq[it][2], (int)hq[2], d, false);
        d = __builtin_amdgcn_sdot4((int)uq[it][3], (int)hq[3], d, false);
        d += __builtin_amdgcn_update_dpp(0, d, 0xB1, 0xf, 0xf, false);
        d += __builtin_amdgcn_update_dpp(0, d, 0x4E, 0xf, 0xf, false);
        d += __builtin_amdgcn_update_dpp(0, d, 0x141, 0xf, 0xf, false);
        if (it < 8) { if (part == it) d0 = d; } else { if (part == it - 8) d1 = d; }
      }
      short* dst = PD + ((size_t)x * 32768 + tok) * 128 + g * 16 + part;
      dst[0] = (short)((d0 + 32) >> 6);
      dst[8] = (short)((d1 + 32) >> 6);
    }
  }
}

__device__ void phase_peer_coef(const Params& p) {
  const int lane = threadIdx.x & 63, w = threadIdx.x >> 6;
  const unsigned short* SELE = (const unsigned short*)(p.ws + OFF_SELE);
  const float* SELG = (const float*)(p.ws + OFF_SELG);
  const short* PD = (const short*)(p.ws + OFF_PD);
  const float* SU = (const float*)(p.ws + OFF_SUV);
  const float* SV = SU + 16384;
  const float* HSC = (const float*)(p.ws + OFF_HSC);
  unsigned char* CQ = p.ws + OFF_CQ;
  float* CSC = (float*)(p.ws + OFF_CSC);
  for (int tok0 = (blockIdx.x * 8 + w) * 4; tok0 < RLAT; tok0 += gridDim.x * 32) {
    int e[4][2], ds[4][2];
    float gt[4][2], hs[4];
#pragma unroll
    for (int tt = 0; tt < 4; ++tt) {
      const int tok = tok0 + tt;
      hs[tt] = HSC[tok];
#pragma unroll
      for (int q = 0; q < 2; ++q) {
        const int pos = lane + 64 * q;
        e[tt][q] = (int)SELE[(size_t)tok * 128 + pos];
        gt[tt][q] = SELG[(size_t)tok * 128 + pos];
        int s = 0;
#pragma unroll
        for (int x = 0; x < 8; ++x) s += (int)PD[((size_t)x * 32768 + tok) * 128 + pos];
        ds[tt][q] = s * 64;
      }
    }
    float su[4][2], sv[4][2];
#pragma unroll
    for (int tt = 0; tt < 4; ++tt)
#pragma unroll
      for (int q = 0; q < 2; ++q) { su[tt][q] = SU[e[tt][q]]; sv[tt][q] = SV[e[tt][q]]; }
#pragma unroll
    for (int tt = 0; tt < 4; ++tt) {
      const int tok = tok0 + tt;
      float coef[2];
#pragma unroll
      for (int q = 0; q < 2; ++q) {
        const float dot = su[tt][q] * hs[tt] * (float)ds[tt][q];
        coef[q] = gt[tt][q] * gelu_tanh(dot) * sv[tt][q];
      }
      float am = fmaxf(fabsf(coef[0]), fabsf(coef[1]));
#pragma unroll
      for (int o = 32; o > 0; o >>= 1) am = fmaxf(am, __shfl_xor(am, o, 64));
      am = fmaxf(am, 1e-30f);
      const float inv = 127.f / am;
      CQ[(size_t)tok * 128 + lane] = (unsigned char)((int)rintf(coef[0] * inv) & 255);
      CQ[(size_t)tok * 128 + 64 + lane] = (unsigned char)((int)rintf(coef[1] * inv) & 255);
      if (lane == 0) CSC[tok] = am * (1.f / 127.f);
    }
  }
}

__device__ void phase_peer_vacc(const Params& p, unsigned char* smem) {
  const int lane = threadIdx.x & 63, w = threadIdx.x >> 6;
  const int g = lane >> 3, part = lane & 7;
  const unsigned short* SELE = (const unsigned short*)(p.ws + OFF_SELE);
  const float* CSC = (const float*)(p.ws + OFF_CSC);
  for (int item = blockIdx.x; item < 256; item += gridDim.x) {
    const int x = item & 7, lb = item >> 3;
    const unsigned char* VS = p.ws + OFF_VQ + (size_t)x * 2097152 + part * 16;
    for (int t = 0; t < 128; ++t) {
      const int tok = lb * 1024 + w * 128 + t;
      const u32x4 cq = *(const u32x4*)(p.ws + OFF_CQ + (size_t)tok * 128 + g * 16);
      int eid[16];
#pragma unroll
      for (int m = 0; m < 2; ++m) {
        const u32x4 e4 = *(const u32x4*)(SELE + (size_t)tok * 128 + g * 16 + m * 8);
#pragma unroll
        for (int q = 0; q < 4; ++q) { eid[8 * m + 2 * q] = (int)(e4[q] & 0xffffu); eid[8 * m + 2 * q + 1] = (int)(e4[q] >> 16); }
      }
      u32x4 vq[16];
#pragma unroll
      for (int it = 0; it < 16; ++it) vq[it] = *(const u32x4*)(VS + (size_t)eid[it] * 128);
      int acc[16];
#pragma unroll
      for (int j = 0; j < 16; ++j) acc[j] = 0;
#pragma unroll
      for (int m = 0; m < 4; ++m) {
#pragma unroll
        for (int c4 = 0; c4 < 4; ++c4) {
          const unsigned a = vq[4 * m][c4], b = vq[4 * m + 1][c4], c = vq[4 * m + 2][c4], d = vq[4 * m + 3][c4];
          const unsigned ab_lo = __builtin_amdgcn_perm(a, b, 0x01050004u), ab_hi = __builtin_amdgcn_perm(a, b, 0x03070206u);
          const unsigned cd_lo = __builtin_amdgcn_perm(c, d, 0x01050004u), cd_hi = __builtin_amdgcn_perm(c, d, 0x03070206u);
          const unsigned col0 = __builtin_amdgcn_perm(ab_lo, cd_lo, 0x01000504u), col1 = __builtin_amdgcn_perm(ab_lo, cd_lo, 0x03020706u);
          const unsigned col2 = __builtin_amdgcn_perm(ab_hi, cd_hi, 0x01000504u), col3 = __builtin_amdgcn_perm(ab_hi, cd_hi, 0x03020706u);
          acc[4 * c4 + 0] = __builtin_amdgcn_sdot4((int)col0, (int)cq[m], acc[4 * c4 + 0], false);
          acc[4 * c4 + 1] = __builtin_amdgcn_sdot4((int)col1, (int)cq[m], acc[4 * c4 + 1], false);
          acc[4 * c4 + 2] = __builtin_amdgcn_sdot4((int)col2, (int)cq[m], acc[4 * c4 + 2], false);
          acc[4 * c4 + 3] = __builtin_amdgcn_sdot4((int)col3, (int)cq[m], acc[4 * c4 + 3], false);
        }
      }
      int* red = (int*)smem + w * 1024;
#pragma unroll
      for (int m = 0; m < 4; ++m) {
        u32x4 t4;
        t4[0] = (unsigned)acc[4 * m]; t4[1] = (unsigned)acc[4 * m + 1]; t4[2] = (unsigned)acc[4 * m + 2]; t4[3] = (unsigned)acc[4 * m + 3];
        *(u32x4*)(red + m * 256 + lane * 4) = t4;
      }
      int s0 = 0, s1 = 0;
#pragma unroll
      for (int gg = 0; gg < 8; ++gg) {
        const uint2 t2 = *(const uint2*)(red + (g >> 1) * 256 + (gg * 8 + part) * 4 + (g & 1) * 2);
        s0 += (int)t2.x;
        s1 += (int)t2.y;
      }
      const float cs = CSC[tok];
      const int col = x * 128 + part * 16 + 2 * g;
      *(unsigned*)((bf16_t*)(p.ws + OFF_QG) + (size_t)tok * 1024 + col) = pack2(cs * (float)s0, cs * (float)s1);
    }
  }
}

__device__ void phase_final_norm(const Params& p) {
  const int lane = threadIdx.x & 63, w = threadIdx.x >> 6;
  const float* mod = (const float*)(p.ws + OFF_MOD);
  const bf16_t* PB = (const bf16_t*)(p.ws + OFF_QG);
  for (int tok = blockIdx.x * 8 + w; tok < RLAT; tok += gridDim.x * 8) {
    const int bb = tok >> 12;
    float* xr = p.out + (size_t)tok * 1024;
    f32x4 v[4];
    float s = 0.f;
#pragma unroll
    for (int m = 0; m < 4; ++m) {
      const int col = (m * 64 + lane) * 4;
      v[m] = *(const f32x4*)(xr + col);
      const uint2 pk = *(const uint2*)(PB + (size_t)tok * 1024 + col);
      const f32x4 gv = *(const f32x4*)(mod + bb * 6144 + 5120 + col);
      v[m][0] += gv[0] * __uint_as_float(pk.x << 16);
      v[m][1] += gv[1] * __uint_as_float(pk.x & 0xffff0000u);
      v[m][2] += gv[2] * __uint_as_float(pk.y << 16);
      v[m][3] += gv[3] * __uint_as_float(pk.y & 0xffff0000u);
      s += v[m][0] * v[m][0] + v[m][1] * v[m][1] + v[m][2] * v[m][2] + v[m][3] * v[m][3];
    }
    s = wave_sum(s);
    const float rs = rsqrtf(s * (1.f / 1024.f) + 1e-6f);
#pragma unroll
    for (int m = 0; m < 4; ++m) {
      const int col = (m * 64 + lane) * 4;
      const f32x4 fg = *(const f32x4*)(p.final_g + col);
      f32x4 o = v[m];
      o[0] *= rs * fg[0]; o[1] *= rs * fg[1]; o[2] *= rs * fg[2]; o[3] *= rs * fg[3];
      *(f32x4*)(xr + col) = o;
    }
  }
}

constexpr size_t OFF_BAR = WS_END + 8388608;
#define XB_TMO      128
#define XB_XCNT(j)  (256  + 64 * (j))
#define XB_XSUB(j)  (1280 + 64 * (j))
#define XB_XGEN(j)  (2304 + 64 * (j))
#define XB_TOP      3328
#define XB_TOPGEN   3392
#define XCD_BAR_WORDS 3456
#define XB_SPIN_CAP (1u << 18)
#define LAS __attribute__((address_space(3)))
__device__ __forceinline__ unsigned xb_ld(unsigned* p)              { return __hip_atomic_load(p, __ATOMIC_RELAXED, __HIP_MEMORY_SCOPE_AGENT); }
__device__ __forceinline__ unsigned xb_add(unsigned* p, unsigned v) { return __hip_atomic_fetch_add(p, v, __ATOMIC_RELAXED, __HIP_MEMORY_SCOPE_AGENT); }
__device__ __forceinline__ unsigned xb_xcc_id() { return (unsigned)__builtin_amdgcn_s_getreg((3 << 11) | 20) & 0xFu; }
#define XB_SPIN(cond, bar) do { unsigned _sp = 0; while (cond) { __builtin_amdgcn_s_sleep(1); \
    if ((++_sp & 255u) == 0u) { if (xb_ld(&(bar)[XB_TMO])) break; if (_sp > XB_SPIN_CAP) { atomicAdd(&(bar)[XB_TMO], 1u); break; } } } } while (0)
struct XcdBarrier { unsigned* bar; unsigned x; volatile LAS unsigned* st; };
__device__ __forceinline__ XcdBarrier xcd_barrier_post(unsigned* bar, volatile LAS unsigned* st) {
  XcdBarrier b; b.bar = bar; b.x = xb_xcc_id(); b.st = st;
  if (threadIdx.x == 0) (void)xb_add(&bar[XB_XCNT(b.x)], 1u);
  return b;
}
__device__ __forceinline__ void xcd_barrier_complete(unsigned* bar, unsigned x, unsigned& nloc, unsigned& nx) {
  const unsigned G = gridDim.x * gridDim.y * gridDim.z;
  unsigned sum, cnt, mine, sp = 0u;
  for (;;) {
    sum = 0u; cnt = 0u; mine = 0u;
#pragma unroll
    for (unsigned j = 0; j < 16; ++j) { const unsigned c = xb_ld(&bar[XB_XCNT(j)]); sum += c; cnt += (c > 0u) ? 1u : 0u; mine = (j == x) ? c : mine; }
    if (sum == G) break;
    __builtin_amdgcn_s_sleep(1);
    if ((++sp & 255u) == 0u) { if (xb_ld(&bar[XB_TMO])) break; if (sp > XB_SPIN_CAP) { atomicAdd(&bar[XB_TMO], 1u); break; } }
  }
  nloc = mine > 0u ? mine : 1u; nx = cnt > 0u ? cnt : 1u;
}
__device__ __forceinline__ void xcd_barrier(const XcdBarrier& b) {
  asm volatile("s_waitcnt vmcnt(0)" ::: "memory");
  __syncthreads();
  if (threadIdx.x == 0) {
    unsigned* bar = b.bar;
    __builtin_amdgcn_s_waitcnt(0);
    unsigned nloc = b.st[0], nx = b.st[1];
    if (nloc == 0u) { xcd_barrier_complete(bar, b.x, nloc, nx); b.st[0] = nloc; b.st[1] = nx; }
    const unsigned old = xb_add(&bar[XB_XSUB(b.x)], 1u);
    const unsigned gen = old / nloc;
    if (old + 1u == (gen + 1u) * nloc) {
      __builtin_amdgcn_fence(__ATOMIC_RELEASE, "agent");
      asm volatile("s_waitcnt vmcnt(0)" ::: "memory");
      const unsigned og = xb_add(&bar[XB_TOP], 1u);
      const unsigned tg = og / nx;
      if (og + 1u == (tg + 1u) * nx) xb_add(&bar[XB_TOPGEN], 1u);
      else XB_SPIN(xb_ld(&bar[XB_TOPGEN]) == tg, bar);
      __builtin_amdgcn_fence(__ATOMIC_ACQUIRE, "agent");
      xb_add(&bar[XB_XGEN(b.x)], 1u);
      asm volatile("s_waitcnt vmcnt(0)" ::: "memory");
    } else {
      XB_SPIN(xb_ld(&bar[XB_XGEN(b.x)]) == gen, bar);
      __builtin_amdgcn_fence(__ATOMIC_ACQUIRE, "agent");
      asm volatile("s_waitcnt vmcnt(0)" ::: "memory");
    }
  }
  __syncthreads();
}

#ifndef PROBE_REP
#define PROBE_REP 0
#endif
__global__ void __launch_bounds__(NT) mega(Params p) {
  extern __shared__ __align__(16) unsigned char smem[];
  cg::grid_group grid = cg::this_grid();
  volatile LAS unsigned* xst = (volatile LAS unsigned*)(smem + LDS_BYTES - 16);
  if (threadIdx.x == 0) { xst[0] = 0u; xst[1] = 0u; }
  __syncthreads();
  const XcdBarrier xbar = xcd_barrier_post((unsigned*)(p.ws + OFF_BAR), xst);
  if (p.ph_lo > 1000) grid.sync();
#define PH(i) (p.ph_lo <= (i) && (i) < p.ph_hi)
#define SYNC(i) if (PH(i) && PH((i) + 1)) xcd_barrier(xbar);
#define RUN(i, body)                                         \
  if (PH(i)) {                                               \
    const int nrep_ = 1 + ((p.rep_mask >> (i)) & 1);         \
    for (int rep_ = 0; rep_ < nrep_; ++rep_) {               \
      if (rep_) xcd_barrier(xbar);                           \
      body;                                                  \
    }                                                        \
  }                                                          \
  SYNC(i)
#define RUN1(i, body) if (PH(i)) { body; } SYNC(i)
  RUN(0, phase0(p, smem))
  RUN(1, norm_mod_rows(p.x, p.ctx, RALL, p.norm1_g, (const float*)(p.ws + OFF_MOD), 0, 1024, (bf16_t*)(p.ws + OFF_KC)))
  RUN(2, phase_inproj(p, smem))
  RUN1(3, {
    u32x4 pr[7];
    float pf[5];
    int item = blockIdx.x;
    if (item < 2176) prepass_preload(p, item, pr, pf);
    for (; item < 2176; item += gridDim.x) gdn_prepass_item(p, item, item + gridDim.x, smem, pr, pf); })
  RUN1(4, {
    const int item = blockIdx.x;
    if (item < 128) gdn_seq_item(p, item, smem);
    else if (item < 256) rglru_item(p, item - 128, smem); })
  RUN(5, { phase_ya(p); phase_quant_uv(p); })
  RUN(6, phase_outproj(p, smem))
  RUN(7, norm_mod_rows(p.out, p.out, RLAT, p.norm2_g, (const float*)(p.ws + OFF_MOD), 3072, 4096, (bf16_t*)(p.ws + OFF_PRG)))
  RUN(8, phase_peer_query(p, smem))
  RUN1(9, phase_peer_select(p, smem))
  RUN1(10, phase_peer_udot(p))
  RUN1(11, phase_peer_coef(p))
  RUN1(12, phase_peer_vacc(p, smem))
  if (PH(13)) phase_final_norm(p);
}

extern "C" void kernel_launch(void* const* d_in, const int* in_sizes, int n_in, void* d_out, int out_size,
                              void* d_ws, size_t ws_size, hipStream_t stream) {
  static int grid_blocks = 0;
  if (grid_blocks == 0) {
    if (ws_size < OFF_BAR + 16384) { fprintf(stderr, "workspace too small: %zu < %zu\n", ws_size, (size_t)WS_END); grid_blocks = -1; return; }
    int dev = 0, cus = 0, per_cu = 0;
    hipGetDevice(&dev);
    hipDeviceGetAttribute(&cus, hipDeviceAttributeMultiprocessorCount, dev);
    if (hipFuncSetAttribute((const void*)mega, hipFuncAttributeMaxDynamicSharedMemorySize, LDS_BYTES) != hipSuccess) {
      fprintf(stderr, "hipFuncSetAttribute failed\n"); grid_blocks = -1; return;
    }
    hipOccupancyMaxActiveBlocksPerMultiprocessor(&per_cu, (const void*)mega, NT, LDS_BYTES);
    if (per_cu < 1) { fprintf(stderr, "occupancy query says %d\n", per_cu); per_cu = 1; }
    (void)hipGetLastError();
    grid_blocks = cus * per_cu;
    if (grid_blocks < 256) { fprintf(stderr, "grid %d < 256: scan phase needs 256 resident blocks\n", grid_blocks); grid_blocks = -1; return; }
  }
  if (grid_blocks < 0) return;
  Params p{};
  const float** pp = (const float**)&p;
  for (int i = 0; i < 24; ++i) pp[i] = (const float*)d_in[i];
  p.out = (float*)d_out;
  p.ws = (unsigned char*)d_ws;
  p.ph_lo = 0;
  p.ph_hi = 14;
  p.rep_mask = PROBE_REP;
  if (hipMemsetAsync((char*)d_ws + OFF_BAR, 0, 16384, stream) != hipSuccess) { fprintf(stderr, "barrier memset failed\n"); return; }
  void* args[] = {&p};
  hipError_t e = hipLaunchCooperativeKernel((const void*)mega, dim3(grid_blocks), dim3(NT), args, LDS_BYTES, stream);
  if (e != hipSuccess) fprintf(stderr, "cooperative launch failed: %s (grid %d)\n", hipGetErrorString(e), grid_blocks);
}
```

```cpp
#include <hip/hip_runtime.h>
#include <hip/hip_cooperative_groups.h>
#include <cstdio>
namespace cg = cooperative_groups;

#define NT 512
typedef __attribute__((ext_vector_type(8))) short bf16x8;
typedef __attribute__((ext_vector_type(16))) float f32x16;
typedef __attribute__((ext_vector_type(4))) float f32x4;
typedef unsigned short bf16_t;
typedef unsigned u32x4 __attribute__((ext_vector_type(4)));

#define MFMA32(a, b, c) __builtin_amdgcn_mfma_f32_32x32x16_bf16((a), (b), (c), 0, 0, 0)
#define MFMA16(a, b, c) __builtin_amdgcn_mfma_f32_16x16x32_bf16((a), (b), (c), 0, 0, 0)

constexpr int RLAT = 32768, RALL = 34816;
constexpr int LDS_BYTES = 155648;
constexpr int NCHUNK = 4352;

constexpr size_t OFF_MOD = 0;
constexpr size_t OFF_WIN = OFF_MOD + 221184;
constexpr size_t OFF_WOUT = OFF_WIN + 6815744;
constexpr size_t OFF_WQ = OFF_WOUT + 2097152;
constexpr size_t OFF_KEYS = OFF_WQ + 4194304;
constexpr size_t OFF_PRG = OFF_KEYS + 65536;
constexpr size_t OFF_PQKV = OFF_PRG + 71303168;
constexpr size_t OFF_PZ = OFF_PQKV + 106954752;
constexpr size_t OFF_PAB = OFF_PZ + 35651584;
constexpr size_t OFF_QG = OFF_PAB + 2228224;
constexpr size_t OFF_KDT = OFF_QG + 71303168;
constexpr size_t OFF_KC = OFF_KDT + 71303168;
constexpr size_t OFF_EGL = OFF_KC + 71303168;
constexpr size_t OFF_H = OFF_EGL + 17408;
constexpr size_t WS_END = OFF_H + 67108864;
constexpr size_t OUT_WV = 0;
constexpr size_t OUT_AT = 71303168;

struct Params {
  const float *x, *c, *ctx, *c_ctx, *w_mod, *b_mod, *norm1_g, *norm2_g, *w_in, *rg_conv_w, *rg_conv_b,
      *rg_gate_w, *rg_gate_b, *rg_lambda, *gdn_conv_w, *gdn_a_log, *gdn_dt_bias, *gdn_norm_g, *w_out,
      *peer_wq, *peer_keys, *peer_u, *peer_v, *final_g;
  float* out;
  unsigned char* ws;
  int ph_lo, ph_hi;
  int rep_mask, pad_;
};

__device__ __forceinline__ bf16_t f2bf(float f) {
  unsigned u = __float_as_uint(f);
  u += 0x7fffu + ((u >> 16) & 1u);
  return (bf16_t)(u >> 16);
}
__device__ __forceinline__ float bf2f(bf16_t b) { return __uint_as_float(((unsigned)b) << 16); }
__device__ __forceinline__ unsigned pack2(float a, float b) { return (unsigned)f2bf(a) | ((unsigned)f2bf(b) << 16); }
__device__ __forceinline__ float wave_sum(float v) {
#pragma unroll
  for (int o = 32; o > 0; o >>= 1) v += __shfl_xor(v, o, 64);
  return v;
}
__device__ __forceinline__ float sigmoidf_(float x) { return 1.f / (1.f + __expf(-x)); }
__device__ __forceinline__ float siluf_(float x) { return x / (1.f + __expf(-x)); }
__device__ __forceinline__ float softplusf_(float x) { return fmaxf(x, 0.f) + log1pf(__expf(-fabsf(x))); }
__device__ __forceinline__ float gelu_tanh(float x) {
  float y = 0.7978845608028654f * (x + 0.044715f * x * x * x);
  return 0.5f * x * (1.f + tanhf(y));
}

__device__ void transpose_tile(const float* W, int N, bf16_t* Wt, int kt, int nt, float* tile) {
  const int tid = threadIdx.x;
  const int k0 = kt * 64, n0 = nt * 64;
#pragma unroll
  for (int i = 0; i < 8; ++i) {
    int r = i * 8 + (tid >> 6), cc = tid & 63, n = n0 + cc;
    tile[r * 65 + cc] = (n < N) ? W[(size_t)(k0 + r) * N + n] : 0.f;
  }
  __syncthreads();
#pragma unroll
  for (int i = 0; i < 8; ++i) {
    int r = i * 8 + (tid >> 6), cc = tid & 63;
    Wt[(size_t)(n0 + r) * 1024 + k0 + cc] = f2bf(tile[cc * 65 + r]);
  }
  __syncthreads();
}

__device__ void phase0(const Params& p, unsigned char* smem) {
  const int tid = threadIdx.x;
  float* mod = (float*)(p.ws + OFF_MOD);
  const int nitems = 96 + 832 + 256 + 512 + 1;
  for (int item = blockIdx.x; item < nitems; item += gridDim.x) {
    if (item < 96) {
      float* sc = (float*)smem;
      float* red = sc + 9 * 1024;
      for (int i = tid; i < 9 * 1024; i += NT) {
        int row = i >> 10, k = i & 1023;
        float v = row < 8 ? p.c[row * 1024 + k] : p.c_ctx[k];
        sc[i] = siluf_(v);
      }
      __syncthreads();
      const int w = tid >> 6, lane = tid & 63;
      const int col = item * 64 + lane;
      float acc[9];
#pragma unroll
      for (int r = 0; r < 9; ++r) acc[r] = 0.f;
      const float* wp = p.w_mod + (size_t)(w * 128) * 6144 + col;
#pragma unroll 8
      for (int k = 0; k < 128; ++k) {
        float wv = wp[(size_t)k * 6144];
#pragma unroll
        for (int r = 0; r < 9; ++r) acc[r] += sc[r * 1024 + w * 128 + k] * wv;
      }
#pragma unroll
      for (int r = 0; r < 9; ++r) red[(w * 9 + r) * 64 + lane] = acc[r];
      __syncthreads();
      for (int i = tid; i < 9 * 64; i += NT) {
        int r = i >> 6, l = i & 63;
        float s = 0.f;
        for (int ww = 0; ww < 8; ++ww) s += red[(ww * 9 + r) * 64 + l];
        int cc = item * 64 + l;
        mod[r * 6144 + cc] = s + p.b_mod[cc];
      }
      __syncthreads();
    } else if (item < 96 + 832) {
      int it = item - 96;
      transpose_tile(p.w_in, 3088, (bf16_t*)(p.ws + OFF_WIN), it & 15, it >> 4, (float*)smem);
    } else if (item < 96 + 832 + 256) {
      int it = item - 928;
      transpose_tile(p.w_out, 1024, (bf16_t*)(p.ws + OFF_WOUT), it & 15, it >> 4, (float*)smem);
    } else if (item < 96 + 832 + 256 + 512) {
      int it = item - 1184;
      transpose_tile(p.peer_wq, 2048, (bf16_t*)(p.ws + OFF_WQ), it & 15, it >> 4, (float*)smem);
    } else {
      bf16_t* kb = (bf16_t*)(p.ws + OFF_KEYS);
      for (int i = tid; i < 2 * 128 * 128; i += NT) kb[i] = f2bf(p.peer_keys[i]);
    }
  }
}

__device__ void norm_mod_rows(const float* src_lat, const float* src_ctx, int nrows, const float* g,
                              const float* mod, int sh_off, int sc_off, bf16_t* dst) {
  const int lane = threadIdx.x & 63, w = threadIdx.x >> 6;
  for (int row = blockIdx.x * 8 + w; row < nrows; row += gridDim.x * 8) {
    const float* xr = row < RLAT ? src_lat + (size_t)row * 1024 : src_ctx + (size_t)(row - RLAT) * 1024;
    const int bb = row < RLAT ? (row >> 12) : 8;
    float4 v[4];
    float ss = 0.f;
#pragma unroll
    for (int m = 0; m < 4; ++m) {
      v[m] = ((const float4*)xr)[m * 64 + lane];
      ss += v[m].x * v[m].x + v[m].y * v[m].y + v[m].z * v[m].z + v[m].w * v[m].w;
    }
    ss = wave_sum(ss);
    const float rstd = rsqrtf(ss * (1.f / 1024.f) + 1e-6f);
#pragma unroll
    for (int m = 0; m < 4; ++m) {
      const int col = (m * 64 + lane) * 4;
      float4 gg = *(const float4*)(g + col);
      float4 sh = *(const float4*)(mod + bb * 6144 + sh_off + col);
      float4 sc = *(const float4*)(mod + bb * 6144 + sc_off + col);
      float y0 = v[m].x * rstd * gg.x * (1.f + sc.x) + sh.x;
      float y1 = v[m].y * rstd * gg.y * (1.f + sc.y) + sh.y;
      float y2 = v[m].z * rstd * gg.z * (1.f + sc.z) + sh.z;
      float y3 = v[m].w * rstd * gg.w * (1.f + sc.w) + sh.w;
      uint2 o;
      o.x = pack2(y0, y1);
      o.y = pack2(y2, y3);
      *(uint2*)(dst + (size_t)row * 1024 + col) = o;
    }
  }
}

__device__ __forceinline__ void gemm_tile(const bf16_t* A, const bf16_t* Bt, f32x16 (&acc)[2][2], unsigned char* smem) {
  const int tid = threadIdx.x, lane = tid & 63, w = tid >> 6;
  const int wm = w >> 1, wn = w & 1;
  const int r = lane & 31, h = lane >> 5;
  u32x4 ra0, ra1, ra2, ra3, rb0, rb1;
#pragma unroll
  for (int i = 0; i < 2; ++i)
#pragma unroll
    for (int j = 0; j < 2; ++j)
#pragma unroll
      for (int q = 0; q < 16; ++q) acc[i][j][q] = 0.f;
  const int srow = tid >> 3, scol = (tid & 7) * 8;
  const bf16_t* Ag = A + (size_t)srow * 1024 + scol;
  const bf16_t* Bg = Bt + (size_t)srow * 1024 + scol;
  const int soff = (srow * 72 + scol) * 2;
#define GLOAD(kt_)                                                   \
  ra0 = *(const u32x4*)(Ag + (kt_) * 64);                            \
  ra1 = *(const u32x4*)(Ag + (size_t)64 * 1024 + (kt_) * 64);        \
  ra2 = *(const u32x4*)(Ag + (size_t)128 * 1024 + (kt_) * 64);       \
  ra3 = *(const u32x4*)(Ag + (size_t)192 * 1024 + (kt_) * 64);       \
  rb0 = *(const u32x4*)(Bg + (kt_) * 64);                            \
  rb1 = *(const u32x4*)(Bg + (size_t)64 * 1024 + (kt_) * 64);
#define SSTORE(buf_)                                                        \
  {                                                                         \
    unsigned char* sb_ = smem + (buf_) * 55296 + soff;                      \
    *(u32x4*)(sb_) = ra0;                                                   \
    *(u32x4*)(sb_ + 64 * 144) = ra1;                                        \
    *(u32x4*)(sb_ + 128 * 144) = ra2;                                       \
    *(u32x4*)(sb_ + 192 * 144) = ra3;                                       \
    *(u32x4*)(sb_ + 36864) = rb0;                                           \
    *(u32x4*)(sb_ + 36864 + 64 * 144) = rb1;                                \
  }
  GLOAD(0)
  __syncthreads();
  SSTORE(0)
  GLOAD(1)
  __syncthreads();
#define KSTEP(ks)                                                                          \
  {                                                                                        \
    bf16x8 a0 = *(const bf16x8*)(As + (wm * 64 + r) * 72 + (ks) * 16 + h * 8);             \
    bf16x8 a1 = *(const bf16x8*)(As + (wm * 64 + 32 + r) * 72 + (ks) * 16 + h * 8);        \
    bf16x8 b0 = *(const bf16x8*)(Bs + (wn * 64 + r) * 72 + (ks) * 16 + h * 8);             \
    bf16x8 b1 = *(const bf16x8*)(Bs + (wn * 64 + 32 + r) * 72 + (ks) * 16 + h * 8);        \
    __builtin_amdgcn_s_setprio(1);                                                         \
    acc[0][0] = MFMA32(a0, b0, acc[0][0]);                                                 \
    acc[0][1] = MFMA32(a0, b1, acc[0][1]);                                                 \
    acc[1][0] = MFMA32(a1, b0, acc[1][0]);                                                 \
    acc[1][1] = MFMA32(a1, b1, acc[1][1]);                                                 \
    __builtin_amdgcn_s_setprio(0);                                                         \
  }
  for (int kt = 0; kt < 16; ++kt) {
    const int cur = kt & 1;
    const bf16_t* As = (const bf16_t*)(smem + cur * 55296);
    const bf16_t* Bs = (const bf16_t*)(smem + cur * 55296 + 36864);
    KSTEP(0)
    __builtin_amdgcn_sched_barrier(0);
    if (kt + 1 < 16) SSTORE(cur ^ 1)
    __builtin_amdgcn_sched_barrier(0);
    if (kt + 2 < 16) { GLOAD(kt + 2) }
    __builtin_amdgcn_sched_barrier(0);
    KSTEP(1)
    KSTEP(2)
    KSTEP(3)
    __syncthreads();
  }
#undef KSTEP
#undef GLOAD
#undef SSTORE
}

__device__ __forceinline__ void store_tile_bf16(const f32x16 (&acc)[2][2], unsigned char* smem, bf16_t* dst, size_t ld) {
  const int lane = threadIdx.x & 63, w = threadIdx.x >> 6;
  const int r = lane & 31, h = lane >> 5;
  bf16_t* Cw = (bf16_t*)(smem + w * 9216);
#pragma unroll
  for (int i = 0; i < 2; ++i)
#pragma unroll
    for (int j = 0; j < 2; ++j)
#pragma unroll
      for (int q = 0; q < 16; ++q)
        Cw[(i * 32 + (q & 3) + 8 * (q >> 2) + 4 * h) * 72 + j * 32 + r] = f2bf(acc[i][j][q]);
#pragma unroll
  for (int it = 0; it < 8; ++it) {
    const int row = (lane >> 3) + 8 * it, seg = lane & 7;
    const u32x4 v = *(const u32x4*)(Cw + row * 72 + seg * 8);
    *(u32x4*)(dst + (size_t)row * ld + seg * 8) = v;
  }
}

__device__ __forceinline__ void gemm_tile256(const bf16_t* A, const bf16_t* Bt, f32x16 (&acc)[4][2], unsigned char* smem) {
  const int tid = threadIdx.x, lane = tid & 63, w = tid >> 6;
  const int wm = w >> 2, wn = w & 3;
  const int r = lane & 31, h = lane >> 5;
  u32x4 ra0, ra1, ra2, ra3, rb0, rb1, rb2, rb3;
#pragma unroll
  for (int i = 0; i < 4; ++i)
#pragma unroll
    for (int j = 0; j < 2; ++j)
#pragma unroll
      for (int q = 0; q < 16; ++q) acc[i][j][q] = 0.f;
  const int srow = tid >> 3, scol = (tid & 7) * 8;
  const bf16_t* Ag = A + (size_t)srow * 1024 + scol;
  const bf16_t* Bg = Bt + (size_t)srow * 1024 + scol;
  const int soff = (srow * 72 + scol) * 2;
#define GLOAD(kt_)                                                   \
  ra0 = *(const u32x4*)(Ag + (kt_) * 64);                            \
  ra1 = *(const u32x4*)(Ag + (size_t)64 * 1024 + (kt_) * 64);        \
  ra2 = *(const u32x4*)(Ag + (size_t)128 * 1024 + (kt_) * 64);       \
  ra3 = *(const u32x4*)(Ag + (size_t)192 * 1024 + (kt_) * 64);       \
  rb0 = *(const u32x4*)(Bg + (kt_) * 64);                            \
  rb1 = *(const u32x4*)(Bg + (size_t)64 * 1024 + (kt_) * 64);        \
  rb2 = *(const u32x4*)(Bg + (size_t)128 * 1024 + (kt_) * 64);       \
  rb3 = *(const u32x4*)(Bg + (size_t)192 * 1024 + (kt_) * 64);
#define SSTORE(buf_)                                                        \
  {                                                                         \
    unsigned char* sb_ = smem + (buf_) * 73728 + soff;                      \
    *(u32x4*)(sb_) = ra0;                                                   \
    *(u32x4*)(sb_ + 64 * 144) = ra1;                                        \
    *(u32x4*)(sb_ + 128 * 144) = ra2;                                       \
    *(u32x4*)(sb_ + 192 * 144) = ra3;                                       \
    *(u32x4*)(sb_ + 36864) = rb0;                                           \
    *(u32x4*)(sb_ + 36864 + 64 * 144) = rb1;                                \
    *(u32x4*)(sb_ + 36864 + 128 * 144) = rb2;                               \
    *(u32x4*)(sb_ + 36864 + 192 * 144) = rb3;                               \
  }
#define KSTEP(ks)                                                                          \
  {                                                                                        \
    bf16x8 b0 = *(const bf16x8*)(Bs + (wn * 64 + r) * 72 + (ks) * 16 + h * 8);             \
    bf16x8 b1 = *(const bf16x8*)(Bs + (wn * 64 + 32 + r) * 72 + (ks) * 16 + h * 8);        \
    bf16x8 a0_ = *(const bf16x8*)(As + (wm * 128 + r) * 72 + (ks) * 16 + h * 8);           \
    bf16x8 a1_ = *(const bf16x8*)(As + (wm * 128 + 32 + r) * 72 + (ks) * 16 + h * 8);      \
    bf16x8 a2_ = *(const bf16x8*)(As + (wm * 128 + 64 + r) * 72 + (ks) * 16 + h * 8);      \
    bf16x8 a3_ = *(const bf16x8*)(As + (wm * 128 + 96 + r) * 72 + (ks) * 16 + h * 8);      \
    __builtin_amdgcn_s_setprio(1);                                                         \
    acc[0][0] = MFMA32(a0_, b0, acc[0][0]); acc[0][1] = MFMA32(a0_, b1, acc[0][1]);        \
    acc[1][0] = MFMA32(a1_, b0, acc[1][0]); acc[1][1] = MFMA32(a1_, b1, acc[1][1]);        \
    acc[2][0] = MFMA32(a2_, b0, acc[2][0]); acc[2][1] = MFMA32(a2_, b1, acc[2][1]);        \
    acc[3][0] = MFMA32(a3_, b0, acc[3][0]); acc[3][1] = MFMA32(a3_, b1, acc[3][1]);        \
    __builtin_amdgcn_s_setprio(0);                                                         \
  }
  GLOAD(0)
  __syncthreads();
  SSTORE(0)
  GLOAD(1)
  __syncthreads();
  for (int kt = 0; kt < 16; ++kt) {
    const int cur = kt & 1;
    const bf16_t* As = (const bf16_t*)(smem + cur * 73728);
    const bf16_t* Bs = (const bf16_t*)(smem + cur * 73728 + 36864);
    KSTEP(0)
    __builtin_amdgcn_sched_barrier(0);
    if (kt + 1 < 16) SSTORE(cur ^ 1)
    __builtin_amdgcn_sched_barrier(0);
    if (kt + 2 < 16) { GLOAD(kt + 2) }
    __builtin_amdgcn_sched_barrier(0);
    KSTEP(1)
    KSTEP(2)
    KSTEP(3)
    __syncthreads();
  }
#undef KSTEP
#undef GLOAD
#undef SSTORE
}

__device__ __forceinline__ void store_half_bf16(const f32x16& a00, const f32x16& a01, const f32x16& a10, const f32x16& a11,
                                                unsigned char* smem, bf16_t* dst, size_t ld) {
  const int lane = threadIdx.x & 63, w = threadIdx.x >> 6;
  const int r = lane & 31, h = lane >> 5;
  bf16_t* Cw = (bf16_t*)(smem + w * 9216);
#pragma unroll
  for (int q = 0; q < 16; ++q) {
    const int rr = (q & 3) + 8 * (q >> 2) + 4 * h;
    Cw[rr * 72 + r] = f2bf(a00[q]);
    Cw[rr * 72 + 32 + r] = f2bf(a01[q]);
    Cw[(32 + rr) * 72 + r] = f2bf(a10[q]);
    Cw[(32 + rr) * 72 + 32 + r] = f2bf(a11[q]);
  }
#pragma unroll
  for (int it = 0; it < 8; ++it) {
    const int row = (lane >> 3) + 8 * it, seg = lane & 7;
    const u32x4 v = *(const u32x4*)(Cw + row * 72 + seg * 8);
    *(u32x4*)(dst + (size_t)row * ld + seg * 8) = v;
  }
}

__device__ void phase_inproj(const Params& p, unsigned char* smem) {
  const bf16_t* XN = (const bf16_t*)(p.ws + OFF_KC);
  const bf16_t* WT = (const bf16_t*)(p.ws + OFF_WIN);
  bf16_t* PRG = (bf16_t*)(p.ws + OFF_PRG);
  bf16_t* PQKV = (bf16_t*)(p.ws + OFF_PQKV);
  bf16_t* PZ = (bf16_t*)(p.ws + OFF_PZ);
  float* PAB = (float*)(p.ws + OFF_PAB);
  const int lane = threadIdx.x & 63, w = threadIdx.x >> 6;
  const int wm = w >> 2, wn = w & 3, r = lane & 31, h = lane >> 5;
  const bool swz = (gridDim.x == 256);
  const int xcd = blockIdx.x & 7;
  const int ntiles = swz ? 17 * 13 : 136 * 13;
  for (int k = swz ? (blockIdx.x >> 3) : blockIdx.x; k < ntiles; k += swz ? 32 : gridDim.x) {
    const int mt = swz ? xcd + 8 * (k / 13) : k / 13, nt = k % 13;
    const int m0 = mt * 256, n0 = nt * 256;
    f32x16 acc[4][2];
    gemm_tile256(XN + (size_t)m0 * 1024, WT + (size_t)n0 * 1024, acc, smem);
    const int nc = n0 + wn * 64;
    if (nc < 3072) {
      bf16_t* dst; size_t ld;
      if (nc < 1024) { dst = PRG + nc; ld = 1024; }
      else if (nc < 2560) { dst = PQKV + (nc - 1024); ld = 1536; }
      else { dst = PZ + (nc - 2560); ld = 512; }
      dst += (size_t)(m0 + wm * 128) * ld;
      store_half_bf16(acc[0][0], acc[0][1], acc[1][0], acc[1][1], smem, dst, ld);
      store_half_bf16(acc[2][0], acc[2][1], acc[3][0], acc[3][1], smem, dst + 64 * ld, ld);
    } else if (nc == 3072 && r < 16) {
#pragma unroll
      for (int i = 0; i < 4; ++i)
#pragma unroll
        for (int q = 0; q < 16; ++q) {
          const size_t grow = m0 + wm * 128 + i * 32 + (q & 3) + 8 * (q >> 2) + 4 * h;
          PAB[grow * 16 + r] = acc[i][0][q];
        }
    }
  }
}

__device__ __forceinline__ int chunk_id(int dir, int b, int h, int ci) { return ((dir * 8 + b) * 4 + h) * 68 + ci; }

typedef __attribute__((address_space(3))) const float lds_cf;
typedef __attribute__((address_space(3))) const bf16_t lds_cb;
typedef __attribute__((address_space(3))) const f32x4 lds_cf4;
typedef __attribute__((address_space(3))) bf16_t lds_b;
template <int DIR, int SRC>
__device__ __forceinline__ void solve_col(lds_cf* A_, lds_cf* vcol, lds_cb* kcol, lds_cf* scale, lds_b* dst) {
  asm volatile("" : "+v"(A_), "+v"(vcol), "+v"(kcol), "+v"(scale), "+v"(dst));
  float sol[64];
#pragma unroll
  for (int i = 0; i < 64; ++i) {
    const int ti = DIR ? 63 - i : i;
    float rv;
    if (SRC == 0) rv = vcol[ti * 128] * scale[i];
    else rv = bf2f(kcol[ti * 136]) * scale[i];
#pragma unroll
    for (int s4 = 0; s4 < (i + 3) / 4; ++s4) {
      const f32x4 a4 = *(lds_cf4*)(A_ + i * 64 + s4 * 4);
      if (s4 * 4 + 0 < i) rv -= a4[0] * sol[s4 * 4 + 0];
      if (s4 * 4 + 1 < i) rv -= a4[1] * sol[s4 * 4 + 1];
      if (s4 * 4 + 2 < i) rv -= a4[2] * sol[s4 * 4 + 2];
      if (s4 * 4 + 3 < i) rv -= a4[3] * sol[s4 * 4 + 3];
    }
    sol[i] = rv;
    dst[i * 256] = f2bf(rv);
    __builtin_amdgcn_sched_barrier(0);
  }
}

__device__ __forceinline__ void prepass_preload(const Params& p, int item, u32x4 (&pr)[7], float (&pf)[5]) {
  int tid = threadIdx.x;
  asm volatile("" : "+v"(tid));
  const bool lat = item < 2048;
  int b, c, h;
  if (lat) { b = item >> 8; c = (item >> 2) & 63; h = item & 3; }
  else { int it = item - 2048; b = it >> 4; c = (it >> 2) & 3; h = it & 3; }
  const int Tseq = lat ? 4096 : 256;
  const bf16_t* PQKV = (const bf16_t*)(p.ws + OFF_PQKV);
  const float* PAB = (const float*)(p.ws + OFF_PAB);
#pragma unroll
  for (int i = 0; i < 7; ++i) {
    const int s = tid + i * NT;
    const int rr = s / 48, q = s % 48;
    const int part = q >> 4, sg = q & 15;
    const int j = c * 64 - 2 + rr;
    u32x4 val = {0u, 0u, 0u, 0u};
    if (s < 67 * 48 && j >= 0 && j < Tseq) {
      const size_t grow = lat ? (size_t)b * 4096 + (size_t)((j & 63) * 64 + (j >> 6)) : (size_t)RLAT + b * 256 + j;
      val = *(const u32x4*)(PQKV + grow * 1536 + part * 512 + h * 128 + sg * 8);
    }
    pr[i] = val;
  }
  pf[0] = 0.f;
}

__device__ __forceinline__ void gdn_prepass_item(const Params& p, int item, int next_item, unsigned char* smem, u32x4 (&pr)[7], float (&pf)[5]) {
  const int tid = threadIdx.x, lane = tid & 63, w = tid >> 6;
  const bool lat = item < 2048;
  int b, c, h;
  if (lat) { b = item >> 8; c = (item >> 2) & 63; h = item & 3; }
  else { int it = item - 2048; b = it >> 4; c = (it >> 2) & 3; h = it & 3; }
  const int Tseq = lat ? 4096 : 256;
  const bf16_t* PQKV = (const bf16_t*)(p.ws + OFF_PQKV);
  const float* PAB = (const float*)(p.ws + OFF_PAB);

  bf16_t* raw = (bf16_t*)smem;
  float* KK = (float*)smem;
  float* QK = KK + 64 * 68;
  bf16_t* qb = (bf16_t*)(smem + 51456);
  bf16_t* kb = qb + 64 * 136;
  float* vf = (float*)(smem + 51456 + 34816);
  float* Am = vf + 64 * 128;
  float* gcs = Am + 2 * 64 * 64;
  float* bet = gcs + 128;
  float* beg = bet + 128;

#pragma unroll
  for (int i = 0; i < 7; ++i) {
    const int s = tid + i * NT;
    if (s < 67 * 48) {
      const int rr = s / 48, q = s % 48;
      *(u32x4*)(raw + rr * 384 + (q >> 4) * 128 + (q & 15) * 8) = pr[i];
    }
  }
  for (int s = tid; s < 4 * 384; s += NT) {
    const int kk = s / 384, q = s % 384;
    Am[s] = p.gdn_conv_w[kk * 1536 + (q >> 7) * 512 + h * 128 + (q & 127)];
  }
  if (tid < 128) {
    const int dir = tid >> 6, i = tid & 63;
    const int tok = dir ? 63 - i : i;
    const int j = c * 64 + tok;
    const size_t grow = lat ? (size_t)b * 4096 + (size_t)((j & 63) * 64 + (j >> 6)) : (size_t)RLAT + b * 256 + j;
    const float a_ = PAB[grow * 16 + dir * 8 + h];
    const float b_ = PAB[grow * 16 + dir * 8 + 4 + h];
    float g = -__expf(p.gdn_a_log[dir * 4 + h]) * softplusf_(a_ + p.gdn_dt_bias[dir * 4 + h]);
    const float be = sigmoidf_(b_);
#pragma unroll
    for (int o = 1; o < 64; o <<= 1) {
      float t = __shfl_up(g, o, 64);
      if (lane >= o) g += t;
    }
    gcs[dir * 64 + i] = g;
    bet[dir * 64 + i] = be;
    beg[dir * 64 + i] = be * __expf(g);
  }
  __syncthreads();
  {
    float* cwL = Am;
    const int i = tid >> 3, sg = tid & 7;
#pragma unroll
    for (int part = 0; part < 3; ++part) {
      float y[16];
#pragma unroll
      for (int d = 0; d < 16; ++d) y[d] = 0.f;
#pragma unroll
      for (int kk = 0; kk < 4; ++kk) {
        const u32x4 r0 = *(const u32x4*)(raw + (i + kk) * 384 + part * 128 + sg * 16);
        const u32x4 r1 = *(const u32x4*)(raw + (i + kk) * 384 + part * 128 + sg * 16 + 8);
        const float* cwp = cwL + kk * 384 + part * 128 + sg * 16;
#pragma unroll
        for (int m = 0; m < 4; ++m) {
          const f32x4 w4 = *(const f32x4*)(cwp + 4 * m);
          const unsigned lo = (m < 2) ? r0[2 * m] : r1[2 * m - 4];
          const unsigned hi = (m < 2) ? r0[2 * m + 1] : r1[2 * m - 3];
          y[4 * m + 0] += w4[0] * __uint_as_float(lo << 16);
          y[4 * m + 1] += w4[1] * __uint_as_float(lo & 0xffff0000u);
          y[4 * m + 2] += w4[2] * __uint_as_float(hi << 16);
          y[4 * m + 3] += w4[3] * __uint_as_float(hi & 0xffff0000u);
        }
      }
      float ss = 0.f;
#pragma unroll
      for (int d = 0; d < 16; ++d) { y[d] = siluf_(y[d]); ss += y[d] * y[d]; }
      if (part < 2) {
        ss += __shfl_xor(ss, 1, 64);
        ss += __shfl_xor(ss, 2, 64);
        ss += __shfl_xor(ss, 4, 64);
        float scl = rsqrtf(ss + 1e-6f);
        if (part == 0) scl *= 0.08838834764831845f;
        bf16_t* dst = (part == 0 ? qb : kb) + i * 136 + sg * 16;
#pragma unroll
        for (int d = 0; d < 16; d += 2) *(unsigned*)(dst + d) = pack2(y[d] * scl, y[d + 1] * scl);
      } else {
#pragma unroll
        for (int d = 0; d < 16; ++d) vf[i * 128 + sg * 16 + d] = y[d];
      }
    }
  }
  __syncthreads();
  {
    const int which = w >> 2, tm = (w >> 1) & 1, tn = w & 1;
    const int r = lane & 31, hh = lane >> 5;
    const bf16_t* Ap = which ? qb : kb;
    f32x16 acc;
#pragma unroll
    for (int q = 0; q < 16; ++q) acc[q] = 0.f;
#pragma unroll
    for (int ks = 0; ks < 8; ++ks) {
      bf16x8 a = *(const bf16x8*)(Ap + (tm * 32 + r) * 136 + ks * 16 + hh * 8);
      bf16x8 bb = *(const bf16x8*)(kb + (tn * 32 + r) * 136 + ks * 16 + hh * 8);
      acc = MFMA32(a, bb, acc);
    }
    float* dst = which ? QK : KK;
#pragma unroll
    for (int q = 0; q < 16; ++q) {
      const int row = tm * 32 + (q & 3) + 8 * (q >> 2) + 4 * hh;
      dst[row * 68 + tn * 32 + r] = acc[q];
    }
  }
  __syncthreads();
  const int cidF = chunk_id(0, b, h, lat ? 4 + c : c);
  const int cidB = chunk_id(1, b, h, lat ? 4 + (63 - c) : 3 - c);
  {
    bf16_t* AT = (bf16_t*)((unsigned char*)p.out + OUT_AT);
    bf16_t* QG = (bf16_t*)(p.ws + OFF_QG);
    bf16_t* KDT = (bf16_t*)(p.ws + OFF_KDT);
    float* EGL = (float*)(p.ws + OFF_EGL);
    for (int e = tid; e < 2 * 64 * 64; e += NT) {
      const int dir = e >> 12, i = (e >> 6) & 63, s = e & 63;
      const int ti = dir ? 63 - i : i, ts = dir ? 63 - s : s;
      Am[e] = (i > s) ? bet[dir * 64 + i] * KK[ti * 68 + ts] * __expf(gcs[dir * 64 + i] - gcs[dir * 64 + s]) : 0.f;
    }
#pragma unroll 1
    for (int t = 0; t < 2; ++t) {
      const int e = tid + t * NT;
      const int dir = e >> 9, i = (e >> 3) & 63, s8 = e & 7;
      const int ti = dir ? 63 - i : i;
      const float gi = gcs[dir * 64 + i];
      float v[8];
#pragma unroll
      for (int k = 0; k < 8; ++k) {
        const int s = s8 * 8 + k;
        const int ts = dir ? 63 - s : s;
        v[k] = (i >= s) ? QK[ti * 68 + ts] * __expf(gi - gcs[dir * 64 + s]) : 0.f;
      }
      u32x4 o;
#pragma unroll
      for (int k = 0; k < 4; ++k) o[k] = pack2(v[2 * k], v[2 * k + 1]);
      *(u32x4*)(AT + (size_t)(dir ? cidB : cidF) * 4096 + i * 64 + s8 * 8) = o;
    }
#pragma unroll 1
    for (int t = 0; t < 4; ++t) {
      const int e = tid + t * NT;
      const int dir = e >> 10, i = (e >> 4) & 63, d8 = e & 15;
      const int ti = dir ? 63 - i : i;
      const float eg = __expf(gcs[dir * 64 + i]);
      const u32x4 qv = *(const u32x4*)(qb + ti * 136 + d8 * 8);
      u32x4 o;
#pragma unroll
      for (int k = 0; k < 4; ++k) o[k] = pack2(__uint_as_float(qv[k] << 16) * eg, __uint_as_float(qv[k] & 0xffff0000u) * eg);
      *(u32x4*)(QG + (size_t)(dir ? cidB : cidF) * 8192 + i * 128 + d8 * 8) = o;
    }
#pragma unroll 1
    for (int t = 0; t < 4; ++t) {
      const int e = tid + t * NT;
      const int dir = e >> 10, i8 = (e >> 7) & 7, d = e & 127;
      const float gl = gcs[dir * 64 + 63];
      float v[8];
#pragma unroll
      for (int k = 0; k < 8; ++k) {
        const int i = i8 * 8 + k;
        const int ti = dir ? 63 - i : i;
        v[k] = bf2f(kb[ti * 136 + d]) * __expf(gl - gcs[dir * 64 + i]);
      }
      u32x4 o;
#pragma unroll
      for (int k = 0; k < 4; ++k) o[k] = pack2(v[2 * k], v[2 * k + 1]);
      *(u32x4*)(KDT + (size_t)(dir ? cidB : cidF) * 8192 + d * 64 + i8 * 8) = o;
    }
    if (tid < 2) EGL[tid ? cidB : cidF] = __expf(gcs[tid * 64 + 63]);
  }
  __syncthreads();
  if (next_item < 2176) prepass_preload(p, next_item, pr, pf);
  {
    const int dir = tid >> 8, cidx = tid & 255;
    lds_b* sdst = (lds_b*)((bf16_t*)smem + (dir * 64) * 256 + cidx);
    if (dir == 0) {
      if (cidx < 128) solve_col<0, 0>((lds_cf*)Am, (lds_cf*)(vf + cidx), (lds_cb*)kb, (lds_cf*)bet, sdst);
      else solve_col<0, 1>((lds_cf*)Am, (lds_cf*)vf, (lds_cb*)(kb + (cidx - 128)), (lds_cf*)beg, sdst);
    } else {
      if (cidx < 128) solve_col<1, 0>((lds_cf*)(Am + 4096), (lds_cf*)(vf + cidx), (lds_cb*)kb, (lds_cf*)(bet + 64), sdst);
      else solve_col<1, 1>((lds_cf*)(Am + 4096), (lds_cf*)vf, (lds_cb*)(kb + (cidx - 128)), (lds_cf*)(beg + 64), sdst);
    }
  }
  __syncthreads();
  {
    bf16_t* WVg = (bf16_t*)((unsigned char*)p.out + OUT_WV);
    bf16_t* KCg = (bf16_t*)(p.ws + OFF_KC);
    const bf16_t* solL = (const bf16_t*)smem;
#pragma unroll 1
    for (int t = 0; t < 8; ++t) {
      const int e = tid + t * NT;
      const int dir = e >> 11, i = (e >> 5) & 63, sg = e & 31;
      const u32x4 v = *(const u32x4*)(solL + (dir * 64 + i) * 256 + sg * 8);
      bf16_t* dstp = (sg < 16) ? WVg + (size_t)(dir ? cidB : cidF) * 8192 + i * 128 + sg * 8
                               : KCg + (size_t)(dir ? cidB : cidF) * 8192 + i * 128 + (sg - 16) * 8;
      *(u32x4*)dstp = v;
    }
  }
  __syncthreads();
}

__device__ void gdn_seq_item(const Params& p, int item, unsigned char* smem) {
  const int tid = threadIdx.x, lane = tid & 63, w = tid >> 6;
  const int dvh = item & 1, h = (item >> 1) & 3, b = (item >> 3) & 7, dir = item >> 6;
  const bf16_t* KC = (const bf16_t*)(p.ws + OFF_KC);
  const bf16_t* QG = (const bf16_t*)(p.ws + OFF_QG);
  const bf16_t* KDT = (const bf16_t*)(p.ws + OFF_KDT);
  const bf16_t* WV = (const bf16_t*)((unsigned char*)p.out + OUT_WV);
  const bf16_t* AT = (const bf16_t*)((unsigned char*)p.out + OUT_AT);
  const float* EGL = (const float*)(p.ws + OFF_EGL);
  bf16_t* Odir = (bf16_t*)(p.ws + OFF_PQKV) + (size_t)dir * RLAT * 512;

  bf16_t* KCs = (bf16_t*)smem;
  bf16_t* QGs = KCs + 64 * 136;
  bf16_t* St = QGs + 64 * 136;
  bf16_t* ATs = St + 64 * 136;
  bf16_t* VnT = ATs + 64 * 72;
  bf16_t* WVs = VnT + 64 * 72;
  bf16_t* KDTs = WVs + 64 * 72;

  const int dkt = w >> 1, dvt = w & 1;
  const int r32 = lane & 31, h32 = lane >> 5;
  const int l15 = lane & 15, q4 = lane >> 4;
  const int tm = w >> 1, tn0 = (w & 1) * 2;
  f32x16 S;
#pragma unroll
  for (int q = 0; q < 16; ++q) S[q] = 0.f;
  for (int i = tid; i < 64 * 136 / 2; i += NT) ((unsigned*)St)[i] = 0u;

  const int cid0 = chunk_id(dir, b, h, 0);
  u32x4 rA[8], rB[8];
  float eglA, eglB;
#define SEQ_LOAD(R, EG, cid_)                                                                 \
  {                                                                                           \
    const size_t base_ = (size_t)(cid_) * 8192;                                               \
    R[0] = *(const u32x4*)(KC + base_ + tid * 8);                                             \
    R[1] = *(const u32x4*)(KC + base_ + (tid + 512) * 8);                                     \
    R[2] = *(const u32x4*)(QG + base_ + tid * 8);                                             \
    R[3] = *(const u32x4*)(QG + base_ + (tid + 512) * 8);                                     \
    R[4] = *(const u32x4*)(KDT + base_ + tid * 8);                                            \
    R[5] = *(const u32x4*)(KDT + base_ + (tid + 512) * 8);                                    \
    R[6] = *(const u32x4*)(AT + (size_t)(cid_) * 4096 + tid * 8);                             \
    R[7] = *(const u32x4*)(WV + base_ + (tid >> 3) * 128 + dvh * 64 + (tid & 7) * 8);        \
    EG = EGL[cid_];                                                                           \
  }
#define SEQ_STORE(R)                                                       \
  {                                                                        \
    *(u32x4*)(KCs + (tid >> 4) * 136 + (tid & 15) * 8) = R[0];             \
    *(u32x4*)(KCs + ((tid + 512) >> 4) * 136 + (tid & 15) * 8) = R[1];     \
    *(u32x4*)(QGs + (tid >> 4) * 136 + (tid & 15) * 8) = R[2];             \
    *(u32x4*)(QGs + ((tid + 512) >> 4) * 136 + (tid & 15) * 8) = R[3];     \
    *(u32x4*)(KDTs + (tid >> 3) * 72 + (tid & 7) * 8) = R[4];              \
    *(u32x4*)(KDTs + ((tid + 512) >> 3) * 72 + (tid & 7) * 8) = R[5];      \
    *(u32x4*)(ATs + (tid >> 3) * 72 + (tid & 7) * 8) = R[6];               \
    *(u32x4*)(WVs + (tid >> 3) * 72 + (tid & 7) * 8) = R[7];               \
  }
  auto compute = [&](const int ci, const float egl) __attribute__((always_inline)) {
    f32x4 accO[2];
#pragma unroll
    for (int t = 0; t < 2; ++t) {
      const int tn = tn0 + t;
      f32x4 accV = {0.f, 0.f, 0.f, 0.f};
      accO[t] = accV;
#pragma unroll
      for (int ks = 0; ks < 4; ++ks) {
        bf16x8 aK = *(const bf16x8*)(KCs + (tm * 16 + l15) * 136 + ks * 32 + q4 * 8);
        bf16x8 aQ = *(const bf16x8*)(QGs + (tm * 16 + l15) * 136 + ks * 32 + q4 * 8);
        bf16x8 bS = *(const bf16x8*)(St + (tn * 16 + l15) * 136 + ks * 32 + q4 * 8);
        accV = MFMA16(aK, bS, accV);
        accO[t] = MFMA16(aQ, bS, accO[t]);
      }
      float vn[4];
#pragma unroll
      for (int q = 0; q < 4; ++q) vn[q] = bf2f(WVs[(tm * 16 + q4 * 4 + q) * 72 + tn * 16 + l15]) - accV[q];
      uint2 pk;
      pk.x = pack2(vn[0], vn[1]);
      pk.y = pack2(vn[2], vn[3]);
      *(uint2*)(VnT + (tn * 16 + l15) * 72 + tm * 16 + q4 * 4) = pk;
    }
    __syncthreads();
#pragma unroll
    for (int t = 0; t < 2; ++t) {
      const int tn = tn0 + t;
#pragma unroll
      for (int ks = 0; ks < 2; ++ks) {
        bf16x8 aA = *(const bf16x8*)(ATs + (tm * 16 + l15) * 72 + ks * 32 + q4 * 8);
        bf16x8 bV = *(const bf16x8*)(VnT + (tn * 16 + l15) * 72 + ks * 32 + q4 * 8);
        accO[t] = MFMA16(aA, bV, accO[t]);
      }
      if (ci >= 4) {
#pragma unroll
        for (int q = 0; q < 4; ++q) {
          const int i = tm * 16 + q4 * 4 + q;
          const int sp = (ci - 4) * 64 + i;
          const int j = dir ? 4095 - sp : sp;
          const int t_r = (j & 63) * 64 + (j >> 6);
          Odir[((size_t)b * 4096 + t_r) * 512 + h * 128 + dvh * 64 + tn * 16 + l15] = f2bf(accO[t][q]);
        }
      }
    }
#pragma unroll
    for (int q = 0; q < 16; ++q) S[q] *= egl;
#pragma unroll
    for (int ks = 0; ks < 4; ++ks) {
      bf16x8 a = *(const bf16x8*)(KDTs + (dkt * 32 + r32) * 72 + ks * 16 + h32 * 8);
      bf16x8 bb = *(const bf16x8*)(VnT + (dvt * 32 + r32) * 72 + ks * 16 + h32 * 8);
      S = MFMA32(a, bb, S);
    }
#pragma unroll
    for (int g = 0; g < 4; ++g) {
      uint2 pk;
      pk.x = pack2(S[4 * g + 0], S[4 * g + 1]);
      pk.y = pack2(S[4 * g + 2], S[4 * g + 3]);
      *(uint2*)(St + (dvt * 32 + r32) * 136 + dkt * 32 + 8 * g + 4 * h32) = pk;
    }
    __syncthreads();
  };
  SEQ_LOAD(rA, eglA, cid0)
  SEQ_LOAD(rB, eglB, cid0 + 1)
  for (int ci = 0; ci < 68; ci += 2) {
    SEQ_STORE(rA)
    const float e0 = eglA;
    __syncthreads();
    if (ci + 2 < 68) SEQ_LOAD(rA, eglA, cid0 + ci + 2)
    compute(ci, e0);
    SEQ_STORE(rB)
    const float e1 = eglB;
    __syncthreads();
    if (ci + 3 < 68) SEQ_LOAD(rB, eglB, cid0 + ci + 3)
    compute(ci + 1, e1);
  }
#undef SEQ_LOAD
#undef SEQ_STORE
}

__device__ __forceinline__ float neg_expm1(float y) {
  return (y > -0.02f) ? -(y + 0.5f * y * y + (1.f / 6.f) * y * y * y) : 1.f - __expf(y);
}
__device__ void rglru_item(const Params& p, int it, unsigned char* smem) {
  const int tid = threadIdx.x, lane = tid & 63, w = tid >> 6;
  const int n = it & 7, b = (it >> 3) & 7, dir = it >> 6;
  const bf16_t* PRG = (const bf16_t*)(p.ws + OFF_PRG);
  bf16_t* Hdir = (bf16_t*)(p.ws + OFF_H) + (size_t)dir * RLAT * 512;
  bf16_t* ur = (bf16_t*)smem;
  bf16_t* xcb = ur + 132 * 72;
  bf16_t* wgt = xcb + 128 * 72;
  float* aL = (float*)(smem + (132 + 128 + 128) * 72 * 2);
  float* bL = aL + 128 * 64;
  float* segA = bL + 128 * 64;
  float* segB = segA + 512;
  for (int i = tid; i < 2 * 64 * 64; i += NT) {
    const int g = i >> 12, d = (i >> 6) & 63, e = i & 63;
    wgt[(g * 64 + e) * 72 + d] = f2bf(p.rg_gate_w[((((size_t)dir * 2 + g) * 8 + n) * 64 + d) * 64 + e]);
  }
  float* cwL = segB + 512;
  if (tid < 320) {
    const int kk = tid >> 6, e = tid & 63;
    cwL[tid] = (kk < 4) ? p.rg_conv_w[kk * 512 + n * 64 + e] : p.rg_conv_b[n * 64 + e];
  }
  const int cseg = tid & 7;
  const int tt = w >> 1, et = w & 1, r32 = lane & 31, h32 = lane >> 5;
  const int eg = et * 32 + r32;
  const float bias_r = p.rg_gate_b[(dir * 2 + 0) * 512 + n * 64 + eg];
  const float bias_i = p.rg_gate_b[(dir * 2 + 1) * 512 + n * 64 + eg];
  const float sp8 = -8.f * softplusf_(-p.rg_lambda[dir * 512 + n * 64 + eg]);
  float hstate = 0.f;
  u32x4 pu0, pu1, pu2;
#define RG_LOAD(tile_)                                                                           \
  {                                                                                              \
    const bool lat_ = (tile_) >= 2;                                                              \
    const int tl_ = lat_ ? (tile_) - 2 : (tile_);                                                \
    const int ntl_ = lat_ ? 32 : 2;                                                              \
    const int t0_ = (dir ? (ntl_ - 1 - tl_) : tl_) * 128;                                        \
    const int Tseq_ = lat_ ? 4096 : 256;                                                         \
    const size_t rbase_ = lat_ ? (size_t)b * 4096 : (size_t)RLAT + b * 256;                      \
    const u32x4 z_ = {0u, 0u, 0u, 0u};                                                           \
    { const int s_ = tid; const int t_ = t0_ - 2 + (s_ >> 3);                                   \
      pu0 = (t_ >= 0 && t_ < Tseq_) ? *(const u32x4*)(PRG + (rbase_ + t_) * 1024 + n * 64 + (s_ & 7) * 8) : z_; } \
    { const int s_ = tid + 512; const int t_ = t0_ - 2 + (s_ >> 3);                             \
      pu1 = (t_ >= 0 && t_ < Tseq_) ? *(const u32x4*)(PRG + (rbase_ + t_) * 1024 + n * 64 + (s_ & 7) * 8) : z_; } \
    { const int s_ = tid + 1024; const int t_ = t0_ - 2 + (s_ >> 3);                            \
      pu2 = (s_ < 1048 && t_ >= 0 && t_ < Tseq_) ? *(const u32x4*)(PRG + (rbase_ + t_) * 1024 + n * 64 + (s_ & 7) * 8) : z_; } \
  }
  RG_LOAD(0)
  for (int tile = 0; tile < 34; ++tile) {
    const bool lat = tile >= 2;
    const int tl = lat ? tile - 2 : tile;
    const int ntl = lat ? 32 : 2;
    const int t0 = (dir ? (ntl - 1 - tl) : tl) * 128;
    *(u32x4*)(ur + (tid >> 3) * 72 + (tid & 7) * 8) = pu0;
    *(u32x4*)(ur + ((tid + 512) >> 3) * 72 + (tid & 7) * 8) = pu1;
    if (tid + 1024 < 1048) *(u32x4*)(ur + ((tid + 1024) >> 3) * 72 + (tid & 7) * 8) = pu2;
    __syncthreads();
    if (tile + 1 < 34) RG_LOAD(tile + 1)
#pragma unroll
    for (int half = 0; half < 2; ++half) {
      const int tok = (tid >> 3) + half * 64;
      float a[8];
      {
        const f32x4 c0 = *(const f32x4*)(cwL + 256 + cseg * 8), c1 = *(const f32x4*)(cwL + 256 + cseg * 8 + 4);
#pragma unroll
        for (int j = 0; j < 4; ++j) { a[j] = c0[j]; a[4 + j] = c1[j]; }
      }
#pragma unroll
      for (int kk = 0; kk < 4; ++kk) {
        const u32x4 uv = *(const u32x4*)(ur + (tok + kk) * 72 + cseg * 8);
        const f32x4 w0 = *(const f32x4*)(cwL + kk * 64 + cseg * 8), w1 = *(const f32x4*)(cwL + kk * 64 + cseg * 8 + 4);
        a[0] += w0[0] * __uint_as_float(uv[0] << 16);
        a[1] += w0[1] * __uint_as_float(uv[0] & 0xffff0000u);
        a[2] += w0[2] * __uint_as_float(uv[1] << 16);
        a[3] += w0[3] * __uint_as_float(uv[1] & 0xffff0000u);
        a[4] += w1[0] * __uint_as_float(uv[2] << 16);
        a[5] += w1[1] * __uint_as_float(uv[2] & 0xffff0000u);
        a[6] += w1[2] * __uint_as_float(uv[3] << 16);
        a[7] += w1[3] * __uint_as_float(uv[3] & 0xffff0000u);
      }
      u32x4 o;
#pragma unroll
      for (int m = 0; m < 4; ++m) o[m] = pack2(a[2 * m], a[2 * m + 1]);
      *(u32x4*)(xcb + tok * 72 + cseg * 8) = o;
    }
    __syncthreads();
    {
      f32x16 accR, accI;
#pragma unroll
      for (int q = 0; q < 16; ++q) { accR[q] = 0.f; accI[q] = 0.f; }
#pragma unroll
      for (int ks = 0; ks < 4; ++ks) {
        bf16x8 a = *(const bf16x8*)(xcb + (tt * 32 + r32) * 72 + ks * 16 + h32 * 8);
        bf16x8 br = *(const bf16x8*)(wgt + (et * 32 + r32) * 72 + ks * 16 + h32 * 8);
        bf16x8 bi = *(const bf16x8*)(wgt + (64 + et * 32 + r32) * 72 + ks * 16 + h32 * 8);
        accR = MFMA32(a, br, accR);
        accI = MFMA32(a, bi, accI);
      }
#pragma unroll
      for (int q = 0; q < 16; ++q) {
        const int tok = tt * 32 + (q & 3) + 8 * (q >> 2) + 4 * h32;
        const float er = __expf(-(accR[q] + bias_r)), ei = __expf(-(accI[q] + bias_i));
        const float dr = 1.f + er, di = 1.f + ei;
        const float inv = __frcp_rn(dr * di);
        const float rr = inv * di, ii = inv * dr;
        const float log_a = sp8 * rr;
        const float av = __expf(log_a);
        const float y = -2.f * log_a;
        const float om = (y < 0.04f) ? y * (1.f - y * (0.5f - y * (1.f / 6.f - y * (1.f / 24.f)))) : 1.f - av * av;
        const float xv = bf2f(xcb[tok * 72 + eg]);
        aL[tok * 64 + eg] = av;
        bL[tok * 64 + eg] = __builtin_amdgcn_sqrtf(om) * (ii * xv);
      }
    }
    __syncthreads();
    float Pk[16], Hk[16];
    {
      float P = 1.f, hl = 0.f;
#pragma unroll
      for (int k = 0; k < 16; ++k) {
        const int s = 16 * w + k;
        const int tok = dir ? 127 - s : s;
        const float av = aL[tok * 64 + lane], bv = bL[tok * 64 + lane];
        hl = av * hl + bv;
        P = P * av;
        Pk[k] = P;
        Hk[k] = hl;
      }
      segA[w * 64 + lane] = P;
      segB[w * 64 + lane] = hl;
    }
    __syncthreads();
    {
      float hin = hstate, my_in = 0.f;
#pragma unroll
      for (int ww = 0; ww < 8; ++ww) {
        if (ww == w) my_in = hin;
        hin = segA[ww * 64 + lane] * hin + segB[ww * 64 + lane];
      }
      hstate = hin;
      if (lat) {
#pragma unroll
        for (int k = 0; k < 16; ++k) {
          const int s = 16 * w + k;
          const int tok = dir ? 127 - s : s;
          Hdir[((size_t)b * 4096 + t0 + tok) * 512 + n * 64 + lane] = f2bf(Pk[k] * my_in + Hk[k]);
        }
      }
    }
  }
  __syncthreads();
#undef RG_LOAD
}

__device__ void phase_ya(const Params& p) {
  const int lane = threadIdx.x & 63, w = threadIdx.x >> 6;
  const bf16_t* PRG = (const bf16_t*)(p.ws + OFF_PRG);
  const bf16_t* PZ = (const bf16_t*)(p.ws + OFF_PZ);
  const bf16_t* HF = (const bf16_t*)(p.ws + OFF_H);
  const bf16_t* HB = HF + (size_t)RLAT * 512;
  const bf16_t* OF = (const bf16_t*)(p.ws + OFF_PQKV);
  const bf16_t* OB = OF + (size_t)RLAT * 512;
  bf16_t* YA = (bf16_t*)(p.ws + OFF_QG);
  for (int row = blockIdx.x * 8 + w; row < RLAT; row += gridDim.x * 8) {
    const int c0 = lane * 8;
    uint4 hf = *(const uint4*)(HF + (size_t)row * 512 + c0);
    uint4 hb = *(const uint4*)(HB + (size_t)row * 512 + c0);
    uint4 gt = *(const uint4*)(PRG + (size_t)row * 1024 + 512 + c0);
    uint4 of = *(const uint4*)(OF + (size_t)row * 512 + c0);
    uint4 ob = *(const uint4*)(OB + (size_t)row * 512 + c0);
    uint4 zz = *(const uint4*)(PZ + (size_t)row * 512 + c0);
    const unsigned* hfp = (const unsigned*)&hf; const unsigned* hbp = (const unsigned*)&hb;
    const unsigned* gtp = (const unsigned*)&gt; const unsigned* ofp = (const unsigned*)&of;
    const unsigned* obp = (const unsigned*)&ob; const unsigned* zzp = (const unsigned*)&zz;
    float y[8], o[8], z[8];
    float ss = 0.f;
#pragma unroll
    for (int q = 0; q < 4; ++q) {
      float hf0 = bf2f((bf16_t)(hfp[q] & 0xffff)), hf1 = bf2f((bf16_t)(hfp[q] >> 16));
      float hb0 = bf2f((bf16_t)(hbp[q] & 0xffff)), hb1 = bf2f((bf16_t)(hbp[q] >> 16));
      float g0 = bf2f((bf16_t)(gtp[q] & 0xffff)), g1 = bf2f((bf16_t)(gtp[q] >> 16));
      y[2 * q] = (hf0 + hb0) * gelu_tanh(g0);
      y[2 * q + 1] = (hf1 + hb1) * gelu_tanh(g1);
      o[2 * q] = bf2f((bf16_t)(ofp[q] & 0xffff)) + bf2f((bf16_t)(obp[q] & 0xffff));
      o[2 * q + 1] = bf2f((bf16_t)(ofp[q] >> 16)) + bf2f((bf16_t)(obp[q] >> 16));
      z[2 * q] = bf2f((bf16_t)(zzp[q] & 0xffff));
      z[2 * q + 1] = bf2f((bf16_t)(zzp[q] >> 16));
      ss += o[2 * q] * o[2 * q] + o[2 * q + 1] * o[2 * q + 1];
    }
    ss += __shfl_xor(ss, 1, 64);
    ss += __shfl_xor(ss, 2, 64);
    ss += __shfl_xor(ss, 4, 64);
    ss += __shfl_xor(ss, 8, 64);
    const float rstd = rsqrtf(ss * (1.f / 128.f) + 1e-6f);
    const int d0 = (lane & 15) * 8;
    uint4 o1, o2;
    unsigned* o1p = (unsigned*)&o1; unsigned* o2p = (unsigned*)&o2;
#pragma unroll
    for (int q = 0; q < 4; ++q) {
      o1p[q] = pack2(y[2 * q], y[2 * q + 1]);
      float a0 = o[2 * q] * rstd * p.gdn_norm_g[d0 + 2 * q] * siluf_(z[2 * q]);
      float a1 = o[2 * q + 1] * rstd * p.gdn_norm_g[d0 + 2 * q + 1] * siluf_(z[2 * q + 1]);
      o2p[q] = pack2(a0, a1);
    }
    *(uint4*)(YA + (size_t)row * 1024 + c0) = o1;
    *(uint4*)(YA + (size_t)row * 1024 + 512 + c0) = o2;
  }
}

__device__ void phase_outproj(const Params& p, unsigned char* smem) {
  const bf16_t* YA = (const bf16_t*)(p.ws + OFF_QG);
  const bf16_t* WT = (const bf16_t*)(p.ws + OFF_WOUT);
  const float* mod = (const float*)(p.ws + OFF_MOD);
  const int lane = threadIdx.x & 63, w = threadIdx.x >> 6;
  const int wm = w >> 2, wn = w & 3, r = lane & 31, h = lane >> 5;
  const bool swz = (gridDim.x == 256);
  const int xcd = blockIdx.x & 7;
  const int ntiles = swz ? 16 * 4 : 128 * 4;
  for (int k = swz ? (blockIdx.x >> 3) : blockIdx.x; k < ntiles; k += swz ? 32 : gridDim.x) {
    const int mt = swz ? xcd + 8 * (k >> 2) : (k >> 2), nt = k & 3;
    const int m0 = mt * 256, n0 = nt * 256;
    f32x16 acc[4][2];
    gemm_tile256(YA + (size_t)m0 * 1024, WT + (size_t)n0 * 1024, acc, smem);
    const int bb = m0 >> 12;
    float* Cf = (float*)(smem + w * 8704);
#pragma unroll
    for (int i = 0; i < 4; ++i) {
#pragma unroll
      for (int j = 0; j < 2; ++j)
#pragma unroll
        for (int q = 0; q < 16; ++q) Cf[((q & 3) + 8 * (q >> 2) + 4 * h) * 68 + j * 32 + r] = acc[i][j][q];
#pragma unroll
      for (int it = 0; it < 8; ++it) {
        const int row = (lane >> 4) + 4 * it, seg = lane & 15;
        const f32x4 av = *(const f32x4*)(Cf + row * 68 + seg * 4);
        const size_t grow = m0 + wm * 128 + i * 32 + row;
        const int n = n0 + wn * 64 + seg * 4;
        const f32x4 xv = *(const f32x4*)(p.x + grow * 1024 + n);
        const f32x4 gv = *(const f32x4*)(mod + bb * 6144 + 2048 + n);
        f32x4 o;
        o[0] = xv[0] + gv[0] * av[0]; o[1] = xv[1] + gv[1] * av[1]; o[2] = xv[2] + gv[2] * av[2]; o[3] = xv[3] + gv[3] * av[3];
        *(f32x4*)(p.out + grow * 1024 + n) = o;
      }
    }
  }
}

#define INS16(list, val)                       \
  {                                            \
    float nv_ = (val);                         \
    _Pragma("unroll") for (int k_ = 0; k_ < 16; ++k_) { \
      float hi_ = fmaxf(list[k_], nv_);        \
      nv_ = fminf(list[k_], nv_);              \
      list[k_] = hi_;                          \
    }                                          \
  }

__device__ __forceinline__ void cswap_desc(float& a, float& b) {
  const float hi = fmaxf(a, b), lo = fminf(a, b);
  a = hi;
  b = lo;
}
__device__ __forceinline__ void bitonic_sort16_desc(float (&a)[16]) {
#pragma unroll
  for (int k = 2; k <= 16; k <<= 1)
#pragma unroll
    for (int j = k >> 1; j > 0; j >>= 1)
#pragma unroll
      for (int i = 0; i < 16; ++i) {
        const int l = i ^ j;
        if (l > i) {
          if ((i & k) == 0) cswap_desc(a[i], a[l]);
          else cswap_desc(a[l], a[i]);
        }
      }
}
__device__ __forceinline__ void merge_top16_desc(float (&a)[16], const float (&b)[16]) {
#pragma unroll
  for (int i = 0; i < 16; ++i) a[i] = fmaxf(a[i], b[15 - i]);
#pragma unroll
  for (int j = 8; j > 0; j >>= 1)
#pragma unroll
    for (int i = 0; i < 16; ++i) {
      const int l = i ^ j;
      if (l > i) cswap_desc(a[i], a[l]);
    }
}

__device__ void phase_peer_query(const Params& p, unsigned char* smem) {
  const bf16_t* H2 = (const bf16_t*)(p.ws + OFF_PRG);
  const bf16_t* WT = (const bf16_t*)(p.ws + OFF_WQ);
  const bf16_t* KEYS = (const bf16_t*)(p.ws + OFF_KEYS);
  float* LISTS = (float*)(p.ws + OFF_PZ);
  bf16_t* Qs = (bf16_t*)smem;
  bf16_t* Ks = (bf16_t*)(smem + 69632);
  const int tid = threadIdx.x, lane = tid & 63, w = tid >> 6;
  const int wm = w >> 1, wn = w & 1, r = lane & 31, h = lane >> 5;
  const bool swz = (gridDim.x == 256);
  const int xcd = blockIdx.x & 7;
  const int ntiles = swz ? 16 * 16 : 128 * 16;
  for (int k = swz ? (blockIdx.x >> 3) : blockIdx.x; k < ntiles; k += swz ? 32 : gridDim.x) {
    int mt, hx;
    if (!swz) { mt = k >> 4; hx = k & 15; }
    else { const int g = k >> 7, kk = k & 127; mt = xcd + 8 * (kk >> 3); hx = g * 8 + (kk & 7); }
    const int m0 = mt * 256, n0 = hx * 128;
    const int xh = hx & 1;
    f32x16 acc[2][2];
    gemm_tile(H2 + (size_t)m0 * 1024, WT + (size_t)n0 * 1024, acc, smem);
#pragma unroll
    for (int i = 0; i < 2; ++i)
#pragma unroll
      for (int j = 0; j < 2; ++j)
#pragma unroll
        for (int q = 0; q < 16; ++q) {
          const int row = wm * 64 + i * 32 + (q & 3) + 8 * (q >> 2) + 4 * h;
          const int col = wn * 64 + j * 32 + r;
          Qs[row * 136 + col] = f2bf(acc[i][j][q]);
        }
#pragma unroll
    for (int i = 0; i < 4; ++i) {
      int seg = tid + 512 * i;
      *(uint4*)(Ks + (seg >> 4) * 136 + (seg & 15) * 8) = *(const uint4*)(KEYS + (size_t)xh * 16384 + seg * 8);
    }
    __syncthreads();
    f32x16 sc[4];
#pragma unroll
    for (int m4 = 0; m4 < 4; ++m4)
#pragma unroll
      for (int q = 0; q < 16; ++q) sc[m4][q] = 0.f;
#pragma unroll
    for (int ks = 0; ks < 8; ++ks) {
      bf16x8 bq = *(const bf16x8*)(Qs + (w * 32 + r) * 136 + ks * 16 + h * 8);
#pragma unroll
      for (int m4 = 0; m4 < 4; ++m4) {
        bf16x8 ak = *(const bf16x8*)(Ks + (m4 * 32 + r) * 136 + ks * 16 + h * 8);
        sc[m4] = MFMA32(ak, bq, sc[m4]);
      }
    }
    float list[16];
#pragma unroll
    for (int m4 = 0; m4 < 4; ++m4) {
      float t[16];
#pragma unroll
      for (int q = 0; q < 16; ++q) {
        const unsigned kidx = (unsigned)(m4 * 32 + (q & 3) + 8 * (q >> 2)) | ((unsigned)h << 2);
        t[q] = __uint_as_float((__float_as_uint(sc[m4][q]) & ~127u) | kidx);
      }
      bitonic_sort16_desc(t);
      if (m4 == 0) {
#pragma unroll
        for (int q = 0; q < 16; ++q) list[q] = t[q];
      } else {
        merge_top16_desc(list, t);
      }
    }
    {
      float other[16];
#pragma unroll
      for (int k = 0; k < 16; ++k) other[k] = __shfl_xor(list[k], 32, 64);
      merge_top16_desc(list, other);
    }
    if (h == 0) {
      const size_t tok = (size_t)m0 + w * 32 + r;
      float4* dst = (float4*)(LISTS + (tok * 16 + hx) * 16);
#pragma unroll
      for (int k = 0; k < 4; ++k) dst[k] = make_float4(list[4 * k], list[4 * k + 1], list[4 * k + 2], list[4 * k + 3]);
    }
    __syncthreads();
  }
}

constexpr size_t OFF_UQ = OFF_KDT;
constexpr size_t OFF_VQ = OFF_KDT + 16777216;
constexpr size_t OFF_SUV = OFF_KC;
constexpr size_t OFF_PD = OFF_KC + 1048576;
constexpr size_t OFF_SELE = OFF_PQKV;
constexpr size_t OFF_SELG = OFF_PQKV + 16777216;
constexpr size_t OFF_HQ = OFF_PQKV + 33554432;
constexpr size_t OFF_HSC = OFF_PQKV + 67108864;
constexpr size_t OFF_CQ = OFF_PQKV + 68157440;
constexpr size_t OFF_CSC = OFF_PQKV + 72351744;
constexpr size_t OFF_SS = OFF_PQKV + 73400320;
__device__ void phase_quant_uv(const Params& p) {
  const int lane = threadIdx.x & 63, w = threadIdx.x >> 6;
  float* SC = (float*)(p.ws + OFF_SUV);
  for (int row = blockIdx.x * 8 + w; row < 32768; row += gridDim.x * 8) {
    const float* src = (row < 16384 ? p.peer_u : p.peer_v) + (size_t)(row & 16383) * 1024 + lane * 16;
    float4 v[4];
    float am = 0.f;
#pragma unroll
    for (int m = 0; m < 4; ++m) {
      v[m] = ((const float4*)src)[m];
      am = fmaxf(am, fmaxf(fmaxf(fabsf(v[m].x), fabsf(v[m].y)), fmaxf(fabsf(v[m].z), fabsf(v[m].w))));
    }
#pragma unroll
    for (int o = 32; o > 0; o >>= 1) am = fmaxf(am, __shfl_xor(am, o, 64));
    am = fmaxf(am, 1e-30f);
    const float inv = 127.f / am;
    u32x4 pk;
#pragma unroll
    for (int m = 0; m < 4; ++m) {
      const unsigned q0 = (unsigned)((int)rintf(v[m].x * inv)) & 255u;
      const unsigned q1 = (unsigned)((int)rintf(v[m].y * inv)) & 255u;
      const unsigned q2 = (unsigned)((int)rintf(v[m].z * inv)) & 255u;
      const unsigned q3 = (unsigned)((int)rintf(v[m].w * inv)) & 255u;
      pk[m] = q0 | (q1 << 8) | (q2 << 16) | (q3 << 24);
    }
    unsigned char* base = p.ws + (row < 16384 ? OFF_UQ : OFF_VQ);
    *(u32x4*)(base + (size_t)(lane >> 3) * 2097152 + (size_t)(row & 16383) * 128 + (lane & 7) * 16) = pk;
    if (lane == 0) SC[row] = am * (1.f / 127.f);
  }
}

__device__ void phase_peer_select(const Params& p, unsigned char* smem) {
  const int tid = threadIdx.x, lane = tid & 63, w = tid >> 6;
  const float* LISTS = (const float*)(p.ws + OFF_PZ);
  unsigned short* SELE = (unsigned short*)(p.ws + OFF_SELE);
  float* SELG = (float*)(p.ws + OFF_SELG);
  int* tab = (int*)smem + tid * 33;
  for (int base = (blockIdx.x * 8 + w) * 8; base < RLAT; base += gridDim.x * 64) {
    const int tok = base + (lane >> 3), hh = lane & 7;
    float s1[16], s2[16];
    const float4* l1 = (const float4*)(LISTS + ((size_t)tok * 16 + hh * 2) * 16);
#pragma unroll
    for (int k = 0; k < 4; ++k) {
      float4 a = l1[k], c2 = l1[4 + k];
      s1[4 * k] = a.x; s1[4 * k + 1] = a.y; s1[4 * k + 2] = a.z; s1[4 * k + 3] = a.w;
      s2[4 * k] = c2.x; s2[4 * k + 1] = c2.y; s2[4 * k + 2] = c2.z; s2[4 * k + 3] = c2.w;
    }
#pragma unroll
    for (int k = 0; k < 16; ++k) {
      tab[k] = (int)(__float_as_uint(s1[k]) & 127u);
      tab[16 + k] = (int)(__float_as_uint(s2[k]) & 127u);
      s1[k] = __uint_as_float(__float_as_uint(s1[k]) & ~127u);
      s2[k] = __uint_as_float(__float_as_uint(s2[k]) & ~127u);
    }
    float list[16];
#pragma unroll
    for (int k = 0; k < 16; ++k) list[k] = -3.0e38f;
#pragma unroll
    for (int i = 0; i < 16; ++i)
#pragma unroll
      for (int j = 0; j < 16; ++j)
        if ((i + 1) * (j + 1) <= 16) {
          const float cs = s1[i] + s2[j];
          const float v = __uint_as_float((__float_as_uint(cs) & ~255u) | (unsigned)(i * 16 + j));
          INS16(list, v);
        }
    float ex[16], sum = 0.f;
#pragma unroll
    for (int k = 0; k < 16; ++k) { ex[k] = __expf(list[k] - list[0]); sum += ex[k]; }
    const float inv = 1.f / sum;
#pragma unroll
    for (int k = 0; k < 16; ++k) {
      const unsigned bits = __float_as_uint(list[k]);
      const int i = (bits >> 4) & 15, j = bits & 15;
      const int idx = hh * 16 + k;
      const int pos = (idx & 7) * 16 + (idx >> 3);
      SELE[(size_t)tok * 128 + pos] = (unsigned short)(tab[i] * 128 + tab[16 + j]);
      SELG[(size_t)tok * 128 + pos] = ex[k] * inv;
    }
  }
  {
    const bf16_t* H2 = (const bf16_t*)(p.ws + OFF_PRG);
    float* HSC = (float*)(p.ws + OFF_HSC);
    for (int tok = blockIdx.x * 8 + w; tok < RLAT; tok += gridDim.x * 8) {
      const u32x4 a = *(const u32x4*)(H2 + (size_t)tok * 1024 + lane * 16);
      const u32x4 b = *(const u32x4*)(H2 + (size_t)tok * 1024 + lane * 16 + 8);
      float v[16];
#pragma unroll
      for (int m = 0; m < 4; ++m) {
        v[2 * m] = __uint_as_float(a[m] << 16); v[2 * m + 1] = __uint_as_float(a[m] & 0xffff0000u);
        v[8 + 2 * m] = __uint_as_float(b[m] << 16); v[8 + 2 * m + 1] = __uint_as_float(b[m] & 0xffff0000u);
      }
      float am = 0.f;
#pragma unroll
      for (int j = 0; j < 16; ++j) am = fmaxf(am, fabsf(v[j]));
#pragma unroll
      for (int o = 32; o > 0; o >>= 1) am = fmaxf(am, __shfl_xor(am, o, 64));
      am = fmaxf(am, 1e-30f);
      const float inv = 127.f / am;
      u32x4 pk;
#pragma unroll
      for (int m = 0; m < 4; ++m) {
        const unsigned q0 = (unsigned)((int)rintf(v[4 * m] * inv)) & 255u;
        const unsigned q1 = (unsigned)((int)rintf(v[4 * m + 1] * inv)) & 255u;
        const unsigned q2 = (unsigned)((int)rintf(v[4 * m + 2] * inv)) & 255u;
        const unsigned q3 = (unsigned)((int)rintf(v[4 * m + 3] * inv)) & 255u;
        pk[m] = q0 | (q1 << 8) | (q2 << 16) | (q3 << 24);
      }
      *(u32x4*)(p.ws + OFF_HQ + (size_t)tok * 1024 + lane * 16) = pk;
      if (lane == 0) HSC[tok] = am * (1.f / 127.f);
    }
  }
}

__device__ void phase_peer_udot(const Params& p) {
  const int lane = threadIdx.x & 63, w = threadIdx.x >> 6;
  const int g = lane >> 3, part = lane & 7;
  const unsigned short* SELE = (const unsigned short*)(p.ws + OFF_SELE);
  short* PD = (short*)(p.ws + OFF_PD);
  for (int item = blockIdx.x; item < 256; item += gridDim.x) {
    const int x = item & 7, lb = item >> 3;
    const unsigned char* US = p.ws + OFF_UQ + (size_t)x * 2097152 + part * 16;
    for (int t = 0; t < 128; ++t) {
      const int tok = lb * 1024 + w * 128 + t;
      const u32x4 hq = *(const u32x4*)(p.ws + OFF_HQ + (size_t)tok * 1024 + x * 128 + part * 16);
      int eid[16];
#pragma unroll
      for (int m = 0; m < 2; ++m) {
        const u32x4 e4 = *(const u32x4*)(SELE + (size_t)tok * 128 + g * 16 + m * 8);
#pragma unroll
        for (int q = 0; q < 4; ++q) { eid[8 * m + 2 * q] = (int)(e4[q] & 0xffffu); eid[8 * m + 2 * q + 1] = (int)(e4[q] >> 16); }
      }
      u32x4 uq[16];
#pragma unroll
      for (int it = 0; it < 16; ++it) uq[it] = *(const u32x4*)(US + (size_t)eid[it] * 128);
      int d0 = 0, d1 = 0;
#pragma unroll
      for (int it = 0; it < 16; ++it) {
        int d = __builtin_amdgcn_sdot4((int)uq[it][0], (int)hq[0], 0, false);
        d = __builtin_amdgcn_sdot4((int)uq[it][1], (int)hq[1], d, false);
        d = __builtin_amdgcn_sdot4((int)uq[it][2], (int)hq[2], d, false);
        d = __builtin_amdgcn_sdot4((int)uq[it][3], (int)hq[3], d, false);
        d += __builtin_amdgcn_update_dpp(0, d, 0xB1, 0xf, 0xf, false);
        d += __builtin_amdgcn_update_dpp(0, d, 0x4E, 0xf, 0xf, false);
        d += __builtin_amdgcn_update_dpp(0, d, 0x141, 0xf, 0xf, false);
        if (it < 8) { if (part == it) d0 = d; } else { if (part == it - 8) d1 = d; }
      }
      short* dst = PD + ((size_t)x * 32768 + tok) * 128 + g * 16 + part;
      dst[0] = (short)((d0 + 32) >> 6);
      dst[8] = (short)((d1 + 32) >> 6);
    }
  }
}

__device__ void phase_peer_coef(const Params& p) {
  const int lane = threadIdx.x & 63, w = threadIdx.x >> 6;
  const unsigned short* SELE = (const unsigned short*)(p.ws + OFF_SELE);
  const float* SELG = (const float*)(p.ws + OFF_SELG);
  const short* PD = (const short*)(p.ws + OFF_PD);
  const float* SU = (const float*)(p.ws + OFF_SUV);
  const float* SV = SU + 16384;
  const float* HSC = (const float*)(p.ws + OFF_HSC);
  unsigned char* CQ = p.ws + OFF_CQ;
  float* CSC = (float*)(p.ws + OFF_CSC);
  for (int tok0 = (blockIdx.x * 8 + w) * 4; tok0 < RLAT; tok0 += gridDim.x * 32) {
    int e[4][2], ds[4][2];
    float gt[4][2], hs[4];
#pragma unroll
    for (int tt = 0; tt < 4; ++tt) {
      const int tok = tok0 + tt;
      hs[tt] = HSC[tok];
#pragma unroll
      for (int q = 0; q < 2; ++q) {
        const int pos = lane + 64 * q;
        e[tt][q] = (int)SELE[(size_t)tok * 128 + pos];
        gt[tt][q] = SELG[(size_t)tok * 128 + pos];
        int s = 0;
#pragma unroll
        for (int x = 0; x < 8; ++x) s += (int)PD[((size_t)x * 32768 + tok) * 128 + pos];
        ds[tt][q] = s * 64;
      }
    }
    float su[4][2], sv[4][2];
#pragma unroll
    for (int tt = 0; tt < 4; ++tt)
#pragma unroll
      for (int q = 0; q < 2; ++q) { su[tt][q] = SU[e[tt][q]]; sv[tt][q] = SV[e[tt][q]]; }
#pragma unroll
    for (int tt = 0; tt < 4; ++tt) {
      const int tok = tok0 + tt;
      float coef[2];
#pragma unroll
      for (int q = 0; q < 2; ++q) {
        const float dot = su[tt][q] * hs[tt] * (float)ds[tt][q];
        coef[q] = gt[tt][q] * gelu_tanh(dot) * sv[tt][q];
      }
      float am = fmaxf(fabsf(coef[0]), fabsf(coef[1]));
#pragma unroll
      for (int o = 32; o > 0; o >>= 1) am = fmaxf(am, __shfl_xor(am, o, 64));
      am = fmaxf(am, 1e-30f);
      const float inv = 127.f / am;
      CQ[(size_t)tok * 128 + lane] = (unsigned char)((int)rintf(coef[0] * inv) & 255);
      CQ[(size_t)tok * 128 + 64 + lane] = (unsigned char)((int)rintf(coef[1] * inv) & 255);
      if (lane == 0) CSC[tok] = am * (1.f / 127.f);
    }
  }
}

__device__ void phase_peer_vacc(const Params& p, unsigned char* smem) {
  const int lane = threadIdx.x & 63, w = threadIdx.x >> 6;
  const int g = lane >> 3, part = lane & 7;
  const unsigned short* SELE = (const unsigned short*)(p.ws + OFF_SELE);
  const float* CSC = (const float*)(p.ws + OFF_CSC);
  for (int item = blockIdx.x; item < 256; item += gridDim.x) {
    const int x = item & 7, lb = item >> 3;
    const unsigned char* VS = p.ws + OFF_VQ + (size_t)x * 2097152 + part * 16;
    for (int t = 0; t < 128; ++t) {
      const int tok = lb * 1024 + w * 128 + t;
      const u32x4 cq = *(const u32x4*)(p.ws + OFF_CQ + (size_t)tok * 128 + g * 16);
      int eid[16];
#pragma unroll
      for (int m = 0; m < 2; ++m) {
        const u32x4 e4 = *(const u32x4*)(SELE + (size_t)tok * 128 + g * 16 + m * 8);
#pragma unroll
        for (int q = 0; q < 4; ++q) { eid[8 * m + 2 * q] = (int)(e4[q] & 0xffffu); eid[8 * m + 2 * q + 1] = (int)(e4[q] >> 16); }
      }
      u32x4 vq[16];
#pragma unroll
      for (int it = 0; it < 16; ++it) vq[it] = *(const u32x4*)(VS + (size_t)eid[it] * 128);
      int acc[16];
#pragma unroll
      for (int j = 0; j < 16; ++j) acc[j] = 0;
#pragma unroll
      for (int m = 0; m < 4; ++m) {
#pragma unroll
        for (int c4 = 0; c4 < 4; ++c4) {
          const unsigned a = vq[4 * m][c4], b = vq[4 * m + 1][c4], c = vq[4 * m + 2][c4], d = vq[4 * m + 3][c4];
          const unsigned ab_lo = __builtin_amdgcn_perm(a, b, 0x01050004u), ab_hi = __builtin_amdgcn_perm(a, b, 0x03070206u);
          const unsigned cd_lo = __builtin_amdgcn_perm(c, d, 0x01050004u), cd_hi = __builtin_amdgcn_perm(c, d, 0x03070206u);
          const unsigned col0 = __builtin_amdgcn_perm(ab_lo, cd_lo, 0x01000504u), col1 = __builtin_amdgcn_perm(ab_lo, cd_lo, 0x03020706u);
          const unsigned col2 = __builtin_amdgcn_perm(ab_hi, cd_hi, 0x01000504u), col3 = __builtin_amdgcn_perm(ab_hi, cd_hi, 0x03020706u);
          acc[4 * c4 + 0] = __builtin_amdgcn_sdot4((int)col0, (int)cq[m], acc[4 * c4 + 0], false);
          acc[4 * c4 + 1] = __builtin_amdgcn_sdot4((int)col1, (int)cq[m], acc[4 * c4 + 1], false);
          acc[4 * c4 + 2] = __builtin_amdgcn_sdot4((int)col2, (int)cq[m], acc[4 * c4 + 2], false);
          acc[4 * c4 + 3] = __builtin_amdgcn_sdot4((int)col3, (int)cq[m], acc[4 * c4 + 3], false);
        }
      }
      int* red = (int*)smem + w * 1024;
#pragma unroll
      for (int m = 0; m < 4; ++m) {
        u32x4 t4;
        t4[0] = (unsigned)acc[4 * m]; t4[1] = (unsigned)acc[4 * m + 1]; t4[2] = (unsigned)acc[4 * m + 2]; t4[3] = (unsigned)acc[4 * m + 3];
        *(u32x4*)(red + m * 256 + lane * 4) = t4;
      }
      int s0 = 0, s1 = 0;
#pragma unroll
      for (int gg = 0; gg < 8; ++gg) {
        const uint2 t2 = *(const uint2*)(red + (g >> 1) * 256 + (gg * 8 + part) * 4 + (g & 1) * 2);
        s0 += (int)t2.x;
        s1 += (int)t2.y;
      }
      const float cs = CSC[tok];
      const int col = x * 128 + part * 16 + 2 * g;
      *(unsigned*)((bf16_t*)(p.ws + OFF_QG) + (size_t)tok * 1024 + col) = pack2(cs * (float)s0, cs * (float)s1);
    }
  }
}

__device__ void phase_final_norm(const Params& p) {
  const int lane = threadIdx.x & 63, w = threadIdx.x >> 6;
  const float* mod = (const float*)(p.ws + OFF_MOD);
  const bf16_t* PB = (const bf16_t*)(p.ws + OFF_QG);
  for (int tok = blockIdx.x * 8 + w; tok < RLAT; tok += gridDim.x * 8) {
    const int bb = tok >> 12;
    float* xr = p.out + (size_t)tok * 1024;
    f32x4 v[4];
    float s = 0.f;
#pragma unroll
    for (int m = 0; m < 4; ++m) {
      const int col = (m * 64 + lane) * 4;
      v[m] = *(const f32x4*)(xr + col);
      const uint2 pk = *(const uint2*)(PB + (size_t)tok * 1024 + col);
      const f32x4 gv = *(const f32x4*)(mod + bb * 6144 + 5120 + col);
      v[m][0] += gv[0] * __uint_as_float(pk.x << 16);
      v[m][1] += gv[1] * __uint_as_float(pk.x & 0xffff0000u);
      v[m][2] += gv[2] * __uint_as_float(pk.y << 16);
      v[m][3] += gv[3] * __uint_as_float(pk.y & 0xffff0000u);
      s += v[m][0] * v[m][0] + v[m][1] * v[m][1] + v[m][2] * v[m][2] + v[m][3] * v[m][3];
    }
    s = wave_sum(s);
    const float rs = rsqrtf(s * (1.f / 1024.f) + 1e-6f);
#pragma unroll
    for (int m = 0; m < 4; ++m) {
      const int col = (m * 64 + lane) * 4;
      const f32x4 fg = *(const f32x4*)(p.final_g + col);
      f32x4 o = v[m];
      o[0] *= rs * fg[0]; o[1] *= rs * fg[1]; o[2] *= rs * fg[2]; o[3] *= rs * fg[3];
      *(f32x4*)(xr + col) = o;
    }
  }
}

constexpr size_t OFF_BAR = WS_END + 8388608;
#define XB_TMO      128
#define XB_XCNT(j)  (256  + 64 * (j))
#define XB_XSUB(j)  (1280 + 64 * (j))
#define XB_XGEN(j)  (2304 + 64 * (j))
#define XB_TOP      3328
#define XB_TOPGEN   3392
#define XCD_BAR_WORDS 3456
#define XB_SPIN_CAP (1u << 18)
#define LAS __attribute__((address_space(3)))
__device__ __forceinline__ unsigned xb_ld(unsigned* p)              { return __hip_atomic_load(p, __ATOMIC_RELAXED, __HIP_MEMORY_SCOPE_AGENT); }
__device__ __forceinline__ unsigned xb_add(unsigned* p, unsigned v) { return __hip_atomic_fetch_add(p, v, __ATOMIC_RELAXED, __HIP_MEMORY_SCOPE_AGENT); }
__device__ __forceinline__ unsigned xb_xcc_id() { return (unsigned)__builtin_amdgcn_s_getreg((3 << 11) | 20) & 0xFu; }
#define XB_SPIN(cond, bar) do { unsigned _sp = 0; while (cond) { __builtin_amdgcn_s_sleep(1); \
    if ((++_sp & 255u) == 0u) { if (xb_ld(&(bar)[XB_TMO])) break; if (_sp > XB_SPIN_CAP) { atomicAdd(&(bar)[XB_TMO], 1u); break; } } } } while (0)
struct XcdBarrier { unsigned* bar; unsigned x; volatile LAS unsigned* st; };
__device__ __forceinline__ XcdBarrier xcd_barrier_post(unsigned* bar, volatile LAS unsigned* st) {
  XcdBarrier b; b.bar = bar; b.x = xb_xcc_id(); b.st = st;
  if (threadIdx.x == 0) (void)xb_add(&bar[XB_XCNT(b.x)], 1u);
  return b;
}
__device__ __forceinline__ void xcd_barrier_complete(unsigned* bar, unsigned x, unsigned& nloc, unsigned& nx) {
  const unsigned G = gridDim.x * gridDim.y * gridDim.z;
  unsigned sum, cnt, mine, sp = 0u;
  for (;;) {
    sum = 0u; cnt = 0u; mine = 0u;
#pragma unroll
    for (unsigned j = 0; j < 16; ++j) { const unsigned c = xb_ld(&bar[XB_XCNT(j)]); sum += c; cnt += (c > 0u) ? 1u : 0u; mine = (j == x) ? c : mine; }
    if (sum == G) break;
    __builtin_amdgcn_s_sleep(1);
    if ((++sp & 255u) == 0u) { if (xb_ld(&bar[XB_TMO])) break; if (sp > XB_SPIN_CAP) { atomicAdd(&bar[XB_TMO], 1u); break; } }
  }
  nloc = mine > 0u ? mine : 1u; nx = cnt > 0u ? cnt : 1u;
}
__device__ __forceinline__ void xcd_barrier(const XcdBarrier& b) {
  asm volatile("s_waitcnt vmcnt(0)" ::: "memory");
  __syncthreads();
  if (threadIdx.x == 0) {
    unsigned* bar = b.bar;
    __builtin_amdgcn_s_waitcnt(0);
    unsigned nloc = b.st[0], nx = b.st[1];
    if (nloc == 0u) { xcd_barrier_complete(bar, b.x, nloc, nx); b.st[0] = nloc; b.st[1] = nx; }
    const unsigned old = xb_add(&bar[XB_XSUB(b.x)], 1u);
    const unsigned gen = old / nloc;
    if (old + 1u == (gen + 1u) * nloc) {
      __builtin_amdgcn_fence(__ATOMIC_RELEASE, "agent");
      asm volatile("s_waitcnt vmcnt(0)" ::: "memory");
      const unsigned og = xb_add(&bar[XB_TOP], 1u);
      const unsigned tg = og / nx;
      if (og + 1u == (tg + 1u) * nx) xb_add(&bar[XB_TOPGEN], 1u);
      else XB_SPIN(xb_ld(&bar[XB_TOPGEN]) == tg, bar);
      __builtin_amdgcn_fence(__ATOMIC_ACQUIRE, "agent");
      xb_add(&bar[XB_XGEN(b.x)], 1u);
      asm volatile("s_waitcnt vmcnt(0)" ::: "memory");
    } else {
      XB_SPIN(xb_ld(&bar[XB_XGEN(b.x)]) == gen, bar);
      __builtin_amdgcn_fence(__ATOMIC_ACQUIRE, "agent");
      asm volatile("s_waitcnt vmcnt(0)" ::: "memory");
    }
  }
  __syncthreads();
}

#ifndef PROBE_REP
#define PROBE_REP 0
#endif
__global__ void __launch_bounds__(NT) mega(Params p) {
  extern __shared__ __align__(16) unsigned char smem[];
  cg::grid_group grid = cg::this_grid();
  volatile LAS unsigned* xst = (volatile LAS unsigned*)(smem + LDS_BYTES - 16);
  if (threadIdx.x == 0) { xst[0] = 0u; xst[1] = 0u; }
  __syncthreads();
  const XcdBarrier xbar = xcd_barrier_post((unsigned*)(p.ws + OFF_BAR), xst);
  if (p.ph_lo > 1000) grid.sync();
#define PH(i) (p.ph_lo <= (i) && (i) < p.ph_hi)
#define SYNC(i) if (PH(i) && PH((i) + 1)) xcd_barrier(xbar);
#define RUN(i, body)                                         \
  if (PH(i)) {                                               \
    const int nrep_ = 1 + ((p.rep_mask >> (i)) & 1);         \
    for (int rep_ = 0; rep_ < nrep_; ++rep_) {               \
      if (rep_) xcd_barrier(xbar);                           \
      body;                                                  \
    }                                                        \
  }                                                          \
  SYNC(i)
#define RUN1(i, body) if (PH(i)) { body; } SYNC(i)
  RUN(0, phase0(p, smem))
  RUN(1, norm_mod_rows(p.x, p.ctx, RALL, p.norm1_g, (const float*)(p.ws + OFF_MOD), 0, 1024, (bf16_t*)(p.ws + OFF_KC)))
  RUN(2, phase_inproj(p, smem))
  RUN1(3, {
    u32x4 pr[7];
    float pf[5];
    int item = blockIdx.x;
    if (item < 2176) prepass_preload(p, item, pr, pf);
    for (; item < 2176; item += gridDim.x) gdn_prepass_item(p, item, item + gridDim.x, smem, pr, pf); })
  RUN1(4, {
    const int item = blockIdx.x;
    if (item < 128) gdn_seq_item(p, item, smem);
    else if (item < 256) rglru_item(p, item - 128, smem); })
  RUN(5, { phase_ya(p); phase_quant_uv(p); })
  RUN(6, phase_outproj(p, smem))
  RUN(7, norm_mod_rows(p.out, p.out, RLAT, p.norm2_g, (const float*)(p.ws + OFF_MOD), 3072, 4096, (bf16_t*)(p.ws + OFF_PRG)))
  RUN(8, phase_peer_query(p, smem))
  RUN1(9, phase_peer_select(p, smem))
  RUN1(10, phase_peer_udot(p))
  RUN1(11, phase_peer_coef(p))
  RUN1(12, phase_peer_vacc(p, smem))
  if (PH(13)) phase_final_norm(p);
}

extern "C" void kernel_launch(void* const* d_in, const int* in_sizes, int n_in, void* d_out, int out_size,
                              void* d_ws, size_t ws_size, hipStream_t stream) {
  static int grid_blocks = 0;
  if (grid_blocks == 0) {
    if (ws_size < OFF_BAR + 16384) { fprintf(stderr, "workspace too small: %zu < %zu\n", ws_size, (size_t)WS_END); grid_blocks = -1; return; }
    int dev = 0, cus = 0, per_cu = 0;
    hipGetDevice(&dev);
    hipDeviceGetAttribute(&cus, hipDeviceAttributeMultiprocessorCount, dev);
    if (hipFuncSetAttribute((const void*)mega, hipFuncAttributeMaxDynamicSharedMemorySize, LDS_BYTES) != hipSuccess) {
      fprintf(stderr, "hipFuncSetAttribute failed\n"); grid_blocks = -1; return;
    }
    hipOccupancyMaxActiveBlocksPerMultiprocessor(&per_cu, (const void*)mega, NT, LDS_BYTES);
    if (per_cu < 1) { fprintf(stderr, "occupancy query says %d\n", per_cu); per_cu = 1; }
    (void)hipGetLastError();
    grid_blocks = cus * per_cu;
    if (grid_blocks < 256) { fprintf(stderr, "grid %d < 256: scan phase needs 256 resident blocks\n", grid_blocks); grid_blocks = -1; return; }
  }
  if (grid_blocks < 0) return;
  Params p{};
  const float** pp = (const float**)&p;
  for (int i = 0; i < 24; ++i) pp[i] = (const float*)d_in[i];
  p.out = (float*)d_out;
  p.ws = (unsigned char*)d_ws;
  p.ph_lo = 0;
  p.ph_hi = 14;
  p.rep_mask = PROBE_REP;
  if (hipMemsetAsync((char*)d_ws + OFF_BAR, 0, 16384, stream) != hipSuccess) { fprintf(stderr, "barrier memset failed\n"); return; }
  void* args[] = {&p};
  hipError_t e = hipLaunchCooperativeKernel((const void*)mega, dim3(grid_blocks), dim3(NT), args, LDS_BYTES, stream);
  if (e != hipSuccess) fprintf(stderr, "cooperative launch failed: %s (grid %d)\n", hipGetErrorString(e), grid_blocks);
}
```

```cpp
#include <hip/hip_runtime.h>
#include <hip/hip_cooperative_groups.h>
#include <cstdio>
namespace cg = cooperative_groups;

#define NT 512
typedef __attribute__((ext_vector_type(8))) short bf16x8;
typedef __attribute__((ext_vector_type(16))) float f32x16;
typedef __attribute__((ext_vector_type(4))) float f32x4;
typedef unsigned short bf16_t;
typedef unsigned u32x4 __attribute__((ext_vector_type(4)));

#define MFMA32(a, b, c) __builtin_amdgcn_mfma_f32_32x32x16_bf16((a), (b), (c), 0, 0, 0)
#define MFMA16(a, b, c) __builtin_amdgcn_mfma_f32_16x16x32_bf16((a), (b), (c), 0, 0, 0)

constexpr int RLAT = 32768, RALL = 34816;
constexpr int LDS_BYTES = 155648;
constexpr int NCHUNK = 4352;

constexpr size_t OFF_MOD = 0;
constexpr size_t OFF_WIN = OFF_MOD + 221184;
constexpr size_t OFF_WOUT = OFF_WIN + 6815744;
constexpr size_t OFF_WQ = OFF_WOUT + 2097152;
constexpr size_t OFF_KEYS = OFF_WQ + 4194304;
constexpr size_t OFF_PRG = OFF_KEYS + 65536;
constexpr size_t OFF_PQKV = OFF_PRG + 71303168;
constexpr size_t OFF_PZ = OFF_PQKV + 106954752;
constexpr size_t OFF_PAB = OFF_PZ + 35651584;
constexpr size_t OFF_QG = OFF_PAB + 2228224;
constexpr size_t OFF_KDT = OFF_QG + 71303168;
constexpr size_t OFF_KC = OFF_KDT + 71303168;
constexpr size_t OFF_EGL = OFF_KC + 71303168;
constexpr size_t OFF_H = OFF_EGL + 17408;
constexpr size_t WS_END = OFF_H + 67108864;
constexpr size_t OUT_WV = 0;
constexpr size_t OUT_AT = 71303168;

struct Params {
  const float *x, *c, *ctx, *c_ctx, *w_mod, *b_mod, *norm1_g, *norm2_g, *w_in, *rg_conv_w, *rg_conv_b,
      *rg_gate_w, *rg_gate_b, *rg_lambda, *gdn_conv_w, *gdn_a_log, *gdn_dt_bias, *gdn_norm_g, *w_out,
      *peer_wq, *peer_keys, *peer_u, *peer_v, *final_g;
  float* out;
  unsigned char* ws;
  int ph_lo, ph_hi;
  int rep_mask, pad_;
};

__device__ __forceinline__ bf16_t f2bf(float f) {
  unsigned u = __float_as_uint(f);
  u += 0x7fffu + ((u >> 16) & 1u);
  return (bf16_t)(u >> 16);
}
__device__ __forceinline__ float bf2f(bf16_t b) { return __uint_as_float(((unsigned)b) << 16); }
__device__ __forceinline__ unsigned pack2(float a, float b) { return (unsigned)f2bf(a) | ((unsigned)f2bf(b) << 16); }
__device__ __forceinline__ float wave_sum(float v) {
#pragma unroll
  for (int o = 32; o > 0; o >>= 1) v += __shfl_xor(v, o, 64);
  return v;
}
__device__ __forceinline__ float sigmoidf_(float x) { return 1.f / (1.f + __expf(-x)); }
__device__ __forceinline__ float siluf_(float x) { return x / (1.f + __expf(-x)); }
__device__ __forceinline__ float softplusf_(float x) { return fmaxf(x, 0.f) + log1pf(__expf(-fabsf(x))); }
__device__ __forceinline__ float gelu_tanh(float x) {
  float y = 0.7978845608028654f * (x + 0.044715f * x * x * x);
  return 0.5f * x * (1.f + tanhf(y));
}

__device__ void transpose_tile(const float* W, int N, bf16_t* Wt, int kt, int nt, float* tile) {
  const int tid = threadIdx.x;
  const int k0 = kt * 64, n0 = nt * 64;
#pragma unroll
  for (int i = 0; i < 8; ++i) {
    int r = i * 8 + (tid >> 6), cc = tid & 63, n = n0 + cc;
    tile[r * 65 + cc] = (n < N) ? W[(size_t)(k0 + r) * N + n] : 0.f;
  }
  __syncthreads();
#pragma unroll
  for (int i = 0; i < 8; ++i) {
    int r = i * 8 + (tid >> 6), cc = tid & 63;
    Wt[(size_t)(n0 + r) * 1024 + k0 + cc] = f2bf(tile[cc * 65 + r]);
  }
  __syncthreads();
}

__device__ void phase0(const Params& p, unsigned char* smem) {
  const int tid = threadIdx.x;
  float* mod = (float*)(p.ws + OFF_MOD);
  const int nitems = 96 + 832 + 256 + 512 + 1;
  for (int item = blockIdx.x; item < nitems; item += gridDim.x) {
    if (item < 96) {
      float* sc = (float*)smem;
      float* red = sc + 9 * 1024;
      for (int i = tid; i < 9 * 1024; i += NT) {
        int row = i >> 10, k = i & 1023;
        float v = row < 8 ? p.c[row * 1024 + k] : p.c_ctx[k];
        sc[i] = siluf_(v);
      }
      __syncthreads();
      const int w = tid >> 6, lane = tid & 63;
      const int col = item * 64 + lane;
      float acc[9];
#pragma unroll
      for (int r = 0; r < 9; ++r) acc[r] = 0.f;
      const float* wp = p.w_mod + (size_t)(w * 128) * 6144 + col;
#pragma unroll 8
      for (int k = 0; k < 128; ++k) {
        float wv = wp[(size_t)k * 6144];
#pragma unroll
        for (int r = 0; r < 9; ++r) acc[r] += sc[r * 1024 + w * 128 + k] * wv;
      }
#pragma unroll
      for (int r = 0; r < 9; ++r) red[(w * 9 + r) * 64 + lane] = acc[r];
      __syncthreads();
      for (int i = tid; i < 9 * 64; i += NT) {
        int r = i >> 6, l = i & 63;
        float s = 0.f;
        for (int ww = 0; ww < 8; ++ww) s += red[(ww * 9 + r) * 64 + l];
        int cc = item * 64 + l;
        mod[r * 6144 + cc] = s + p.b_mod[cc];
      }
      __syncthreads();
    } else if (item < 96 + 832) {
      int it = item - 96;
      transpose_tile(p.w_in, 3088, (bf16_t*)(p.ws + OFF_WIN), it & 15, it >> 4, (float*)smem);
    } else if (item < 96 + 832 + 256) {
      int it = item - 928;
      transpose_tile(p.w_out, 1024, (bf16_t*)(p.ws + OFF_WOUT), it & 15, it >> 4, (float*)smem);
    } else if (item < 96 + 832 + 256 + 512) {
      int it = item - 1184;
      transpose_tile(p.peer_wq, 2048, (bf16_t*)(p.ws + OFF_WQ), it & 15, it >> 4, (float*)smem);
    } else {
      bf16_t* kb = (bf16_t*)(p.ws + OFF_KEYS);
      for (int i = tid; i < 2 * 128 * 128; i += NT) kb[i] = f2bf(p.peer_keys[i]);
    }
  }
}

__device__ void norm_mod_rows(const float* src_lat, const float* src_ctx, int nrows, const float* g,
                              const float* mod, int sh_off, int sc_off, bf16_t* dst) {
  const int lane = threadIdx.x & 63, w = threadIdx.x >> 6;
  for (int row = blockIdx.x * 8 + w; row < nrows; row += gridDim.x * 8) {
    const float* xr = row < RLAT ? src_lat + (size_t)row * 1024 : src_ctx + (size_t)(row - RLAT) * 1024;
    const int bb = row < RLAT ? (row >> 12) : 8;
    float4 v[4];
    float ss = 0.f;
#pragma unroll
    for (int m = 0; m < 4; ++m) {
      v[m] = ((const float4*)xr)[m * 64 + lane];
      ss += v[m].x * v[m].x + v[m].y * v[m].y + v[m].z * v[m].z + v[m].w * v[m].w;
    }
    ss = wave_sum(ss);
    const float rstd = rsqrtf(ss * (1.f / 1024.f) + 1e-6f);
#pragma unroll
    for (int m = 0; m < 4; ++m) {
      const int col = (m * 64 + lane) * 4;
      float4 gg = *(const float4*)(g + col);
      float4 sh = *(const float4*)(mod + bb * 6144 + sh_off + col);
      float4 sc = *(const float4*)(mod + bb * 6144 + sc_off + col);
      float y0 = v[m].x * rstd * gg.x * (1.f + sc.x) + sh.x;
      float y1 = v[m].y * rstd * gg.y * (1.f + sc.y) + sh.y;
      float y2 = v[m].z * rstd * gg.z * (1.f + sc.z) + sh.z;
      float y3 = v[m].w * rstd * gg.w * (1.f + sc.w) + sh.w;
      uint2 o;
      o.x = pack2(y0, y1);
      o.y = pack2(y2, y3);
      *(uint2*)(dst + (size_t)row * 1024 + col) = o;
    }
  }
}

__device__ __forceinline__ void gemm_tile(const bf16_t* A, const bf16_t* Bt, f32x16 (&acc)[2][2], unsigned char* smem) {
  const int tid = threadIdx.x, lane = tid & 63, w = tid >> 6;
  const int wm = w >> 1, wn = w & 1;
  const int r = lane & 31, h = lane >> 5;
  u32x4 ra0, ra1, ra2, ra3, rb0, rb1;
#pragma unroll
  for (int i = 0; i < 2; ++i)
#pragma unroll
    for (int j = 0; j < 2; ++j)
#pragma unroll
      for (int q = 0; q < 16; ++q) acc[i][j][q] = 0.f;
  const int srow = tid >> 3, scol = (tid & 7) * 8;
  const bf16_t* Ag = A + (size_t)srow * 1024 + scol;
  const bf16_t* Bg = Bt + (size_t)srow * 1024 + scol;
  const int soff = (srow * 72 + scol) * 2;
#define GLOAD(kt_)                                                   \
  ra0 = *(const u32x4*)(Ag + (kt_) * 64);                            \
  ra1 = *(const u32x4*)(Ag + (size_t)64 * 1024 + (kt_) * 64);        \
  ra2 = *(const u32x4*)(Ag + (size_t)128 * 1024 + (kt_) * 64);       \
  ra3 = *(const u32x4*)(Ag + (size_t)192 * 1024 + (kt_) * 64);       \
  rb0 = *(const u32x4*)(Bg + (kt_) * 64);                            \
  rb1 = *(const u32x4*)(Bg + (size_t)64 * 1024 + (kt_) * 64);
#define SSTORE(buf_)                                                        \
  {                                                                         \
    unsigned char* sb_ = smem + (buf_) * 55296 + soff;                      \
    *(u32x4*)(sb_) = ra0;                                                   \
    *(u32x4*)(sb_ + 64 * 144) = ra1;                                        \
    *(u32x4*)(sb_ + 128 * 144) = ra2;                                       \
    *(u32x4*)(sb_ + 192 * 144) = ra3;                                       \
    *(u32x4*)(sb_ + 36864) = rb0;                                           \
    *(u32x4*)(sb_ + 36864 + 64 * 144) = rb1;                                \
  }
  GLOAD(0)
  __syncthreads();
  SSTORE(0)
  GLOAD(1)
  __syncthreads();
#define KSTEP(ks)                                                                          \
  {                                                                                        \
    bf16x8 a0 = *(const bf16x8*)(As + (wm * 64 + r) * 72 + (ks) * 16 + h * 8);             \
    bf16x8 a1 = *(const bf16x8*)(As + (wm * 64 + 32 + r) * 72 + (ks) * 16 + h * 8);        \
    bf16x8 b0 = *(const bf16x8*)(Bs + (wn * 64 + r) * 72 + (ks) * 16 + h * 8);             \
    bf16x8 b1 = *(const bf16x8*)(Bs + (wn * 64 + 32 + r) * 72 + (ks) * 16 + h * 8);        \
    __builtin_amdgcn_s_setprio(1);                                                         \
    acc[0][0] = MFMA32(a0, b0, acc[0][0]);                                                 \
    acc[0][1] = MFMA32(a0, b1, acc[0][1]);                                                 \
    acc[1][0] = MFMA32(a1, b0, acc[1][0]);                                                 \
    acc[1][1] = MFMA32(a1, b1, acc[1][1]);                                                 \
    __builtin_amdgcn_s_setprio(0);                                                         \
  }
  for (int kt = 0; kt < 16; ++kt) {
    const int cur = kt & 1;
    const bf16_t* As = (const bf16_t*)(smem + cur * 55296);
    const bf16_t* Bs = (const bf16_t*)(smem + cur * 55296 + 36864);
    KSTEP(0)
    __builtin_amdgcn_sched_barrier(0);
    if (kt + 1 < 16) SSTORE(cur ^ 1)
    __builtin_amdgcn_sched_barrier(0);
    if (kt + 2 < 16) { GLOAD(kt + 2) }
    __builtin_amdgcn_sched_barrier(0);
    KSTEP(1)
    KSTEP(2)
    KSTEP(3)
    __syncthreads();
  }
#undef KSTEP
#undef GLOAD
#undef SSTORE
}

__device__ __forceinline__ void store_tile_bf16(const f32x16 (&acc)[2][2], unsigned char* smem, bf16_t* dst, size_t ld) {
  const int lane = threadIdx.x & 63, w = threadIdx.x >> 6;
  const int r = lane & 31, h = lane >> 5;
  bf16_t* Cw = (bf16_t*)(smem + w * 9216);
#pragma unroll
  for (int i = 0; i < 2; ++i)
#pragma unroll
    for (int j = 0; j < 2; ++j)
#pragma unroll
      for (int q = 0; q < 16; ++q)
        Cw[(i * 32 + (q & 3) + 8 * (q >> 2) + 4 * h) * 72 + j * 32 + r] = f2bf(acc[i][j][q]);
#pragma unroll
  for (int it = 0; it < 8; ++it) {
    const int row = (lane >> 3) + 8 * it, seg = lane & 7;
    const u32x4 v = *(const u32x4*)(Cw + row * 72 + seg * 8);
    *(u32x4*)(dst + (size_t)row * ld + seg * 8) = v;
  }
}

__device__ __forceinline__ void gemm_tile256(const bf16_t* A, const bf16_t* Bt, f32x16 (&acc)[4][2], unsigned char* smem) {
  const int tid = threadIdx.x, lane = tid & 63, w = tid >> 6;
  const int wm = w >> 2, wn = w & 3;
  const int r = lane & 31, h = lane >> 5;
  u32x4 ra0, ra1, ra2, ra3, rb0, rb1, rb2, rb3;
#pragma unroll
  for (int i = 0; i < 4; ++i)
#pragma unroll
    for (int j = 0; j < 2; ++j)
#pragma unroll
      for (int q = 0; q < 16; ++q) acc[i][j][q] = 0.f;
  const int srow = tid >> 3, scol = (tid & 7) * 8;
  const bf16_t* Ag = A + (size_t)srow * 1024 + scol;
  const bf16_t* Bg = Bt + (size_t)srow * 1024 + scol;
  const int soff = (srow * 72 + scol) * 2;
#define GLOAD(kt_)                                                   \
  ra0 = *(const u32x4*)(Ag + (kt_) * 64);                            \
  ra1 = *(const u32x4*)(Ag + (size_t)64 * 1024 + (kt_) * 64);        \
  ra2 = *(const u32x4*)(Ag + (size_t)128 * 1024 + (kt_) * 64);       \
  ra3 = *(const u32x4*)(Ag + (size_t)192 * 1024 + (kt_) * 64);       \
  rb0 = *(const u32x4*)(Bg + (kt_) * 64);                            \
  rb1 = *(const u32x4*)(Bg + (size_t)64 * 1024 + (kt_) * 64);        \
  rb2 = *(const u32x4*)(Bg + (size_t)128 * 1024 + (kt_) * 64);       \
  rb3 = *(const u32x4*)(Bg + (size_t)192 * 1024 + (kt_) * 64);
#define SSTORE(buf_)                                                        \
  {                                                                         \
    unsigned char* sb_ = smem + (buf_) * 73728 + soff;                      \
    *(u32x4*)(sb_) = ra0;                                                   \
    *(u32x4*)(sb_ + 64 * 144) = ra1;                                        \
    *(u32x4*)(sb_ + 128 * 144) = ra2;                                       \
    *(u32x4*)(sb_ + 192 * 144) = ra3;                                       \
    *(u32x4*)(sb_ + 36864) = rb0;                                           \
    *(u32x4*)(sb_ + 36864 + 64 * 144) = rb1;                                \
    *(u32x4*)(sb_ + 36864 + 128 * 144) = rb2;                               \
    *(u32x4*)(sb_ + 36864 + 192 * 144) = rb3;                               \
  }
#define KSTEP(ks)                                                                          \
  {                                                                                        \
    bf16x8 b0 = *(const bf16x8*)(Bs + (wn * 64 + r) * 72 + (ks) * 16 + h * 8);             \
    bf16x8 b1 = *(const bf16x8*)(Bs + (wn * 64 + 32 + r) * 72 + (ks) * 16 + h * 8);        \
    bf16x8 a0_ = *(const bf16x8*)(As + (wm * 128 + r) * 72 + (ks) * 16 + h * 8);           \
    bf16x8 a1_ = *(const bf16x8*)(As + (wm * 128 + 32 + r) * 72 + (ks) * 16 + h * 8);      \
    bf16x8 a2_ = *(const bf16x8*)(As + (wm * 128 + 64 + r) * 72 + (ks) * 16 + h * 8);      \
    bf16x8 a3_ = *(const bf16x8*)(As + (wm * 128 + 96 + r) * 72 + (ks) * 16 + h * 8);      \
    __builtin_amdgcn_s_setprio(1);                                                         \
    acc[0][0] = MFMA32(a0_, b0, acc[0][0]); acc[0][1] = MFMA32(a0_, b1, acc[0][1]);        \
    acc[1][0] = MFMA32(a1_, b0, acc[1][0]); acc[1][1] = MFMA32(a1_, b1, acc[1][1]);        \
    acc[2][0] = MFMA32(a2_, b0, acc[2][0]); acc[2][1] = MFMA32(a2_, b1, acc[2][1]);        \
    acc[3][0] = MFMA32(a3_, b0, acc[3][0]); acc[3][1] = MFMA32(a3_, b1, acc[3][1]);        \
    __builtin_amdgcn_s_setprio(0);                                                         \
  }
  GLOAD(0)
  __syncthreads();
  SSTORE(0)
  GLOAD(1)
  __syncthreads();
  for (int kt = 0; kt < 16; ++kt) {
    const int cur = kt & 1;
    const bf16_t* As = (const bf16_t*)(smem + cur * 73728);
    const bf16_t* Bs = (const bf16_t*)(smem + cur * 73728 + 36864);
    KSTEP(0)
    __builtin_amdgcn_sched_barrier(0);
    if (kt + 1 < 16) SSTORE(cur ^ 1)
    __builtin_amdgcn_sched_barrier(0);
    if (kt + 2 < 16) { GLOAD(kt + 2) }
    __builtin_amdgcn_sched_barrier(0);
    KSTEP(1)
    KSTEP(2)
    KSTEP(3)
    __syncthreads();
  }
#undef KSTEP
#undef GLOAD
#undef SSTORE
}

__device__ __forceinline__ void store_half_bf16(const f32x16& a00, const f32x16& a01, const f32x16& a10, const f32x16& a11,
                                                unsigned char* smem, bf16_t* dst, size_t ld) {
  const int lane = threadIdx.x & 63, w = threadIdx.x >> 6;
  const int r = lane & 31, h = lane >> 5;
  bf16_t* Cw = (bf16_t*)(smem + w * 9216);
#pragma unroll
  for (int q = 0; q < 16; ++q) {
    const int rr = (q & 3) + 8 * (q >> 2) + 4 * h;
    Cw[rr * 72 + r] = f2bf(a00[q]);
    Cw[rr * 72 + 32 + r] = f2bf(a01[q]);
    Cw[(32 + rr) * 72 + r] = f2bf(a10[q]);
    Cw[(32 + rr) * 72 + 32 + r] = f2bf(a11[q]);
  }
#pragma unroll
  for (int it = 0; it < 8; ++it) {
    const int row = (lane >> 3) + 8 * it, seg = lane & 7;
    const u32x4 v = *(const u32x4*)(Cw + row * 72 + seg * 8);
    *(u32x4*)(dst + (size_t)row * ld + seg * 8) = v;
  }
}

__device__ void phase_inproj(const Params& p, unsigned char* smem) {
  const bf16_t* XN = (const bf16_t*)(p.ws + OFF_KC);
  const bf16_t* WT = (const bf16_t*)(p.ws + OFF_WIN);
  bf16_t* PRG = (bf16_t*)(p.ws + OFF_PRG);
  bf16_t* PQKV = (bf16_t*)(p.ws + OFF_PQKV);
  bf16_t* PZ = (bf16_t*)(p.ws + OFF_PZ);
  float* PAB = (float*)(p.ws + OFF_PAB);
  const int lane = threadIdx.x & 63, w = threadIdx.x >> 6;
  const int wm = w >> 2, wn = w & 3, r = lane & 31, h = lane >> 5;
  const bool swz = (gridDim.x == 256);
  const int xcd = blockIdx.x & 7;
  const int ntiles = swz ? 17 * 13 : 136 * 13;
  for (int k = swz ? (blockIdx.x >> 3) : blockIdx.x; k < ntiles; k += swz ? 32 : gridDim.x) {
    const int mt = swz ? xcd + 8 * (k / 13) : k / 13, nt = k % 13;
    const int m0 = mt * 256, n0 = nt * 256;
    f32x16 acc[4][2];
    gemm_tile256(XN + (size_t)m0 * 1024, WT + (size_t)n0 * 1024, acc, smem);
    const int nc = n0 + wn * 64;
    if (nc < 3072) {
      bf16_t* dst; size_t ld;
      if (nc < 1024) { dst = PRG + nc; ld = 1024; }
      else if (nc < 2560) { dst = PQKV + (nc - 1024); ld = 1536; }
      else { dst = PZ + (nc - 2560); ld = 512; }
      dst += (size_t)(m0 + wm * 128) * ld;
      store_half_bf16(acc[0][0], acc[0][1], acc[1][0], acc[1][1], smem, dst, ld);
      store_half_bf16(acc[2][0], acc[2][1], acc[3][0], acc[3][1], smem, dst + 64 * ld, ld);
    } else if (nc == 3072 && r < 16) {
#pragma unroll
      for (int i = 0; i < 4; ++i)
#pragma unroll
        for (int q = 0; q < 16; ++q) {
          const size_t grow = m0 + wm * 128 + i * 32 + (q & 3) + 8 * (q >> 2) + 4 * h;
          PAB[grow * 16 + r] = acc[i][0][q];
        }
    }
  }
}

__device__ __forceinline__ int chunk_id(int dir, int b, int h, int ci) { return ((dir * 8 + b) * 4 + h) * 68 + ci; }

typedef __attribute__((address_space(3))) const float lds_cf;
typedef __attribute__((address_space(3))) const bf16_t lds_cb;
typedef __attribute__((address_space(3))) const f32x4 lds_cf4;
typedef __attribute__((address_space(3))) bf16_t lds_b;
template <int DIR, int SRC>
__device__ __forceinline__ void solve_col(lds_cf* A_, lds_cf* vcol, lds_cb* kcol, lds_cf* scale, lds_b* dst) {
  asm volatile("" : "+v"(A_), "+v"(vcol), "+v"(kcol), "+v"(scale), "+v"(dst));
  float sol[64];
  float rraw = (SRC == 0) ? vcol[(DIR ? 63 : 0) * 128] : bf2f(kcol[(DIR ? 63 : 0) * 136]);
  float rsc = scale[0];
  f32x4 acur = {0.f, 0.f, 0.f, 0.f};
#pragma unroll
  for (int i = 0; i < 64; ++i) {
    float rv = rraw * rsc;
    float nraw = 0.f, nsc = 0.f;
    f32x4 anext = {0.f, 0.f, 0.f, 0.f};
    if (i + 1 < 64) {
      const int tn = DIR ? 63 - (i + 1) : (i + 1);
      nraw = (SRC == 0) ? vcol[tn * 128] : bf2f(kcol[tn * 136]);
      nsc = scale[i + 1];
      anext = *(lds_cf4*)(A_ + (i + 1) * 64);
    }
#pragma unroll
    for (int s4 = 0; s4 < (i + 3) / 4; ++s4) {
      f32x4 a4;
      if (s4 == 0) a4 = acur;
      else a4 = *(lds_cf4*)(A_ + i * 64 + s4 * 4);
      if (s4 * 4 + 0 < i) rv -= a4[0] * sol[s4 * 4 + 0];
      if (s4 * 4 + 1 < i) rv -= a4[1] * sol[s4 * 4 + 1];
      if (s4 * 4 + 2 < i) rv -= a4[2] * sol[s4 * 4 + 2];
      if (s4 * 4 + 3 < i) rv -= a4[3] * sol[s4 * 4 + 3];
    }
    sol[i] = rv;
    dst[i * 256] = f2bf(rv);
    rraw = nraw; rsc = nsc; acur = anext;
    __builtin_amdgcn_sched_barrier(0);
  }
}

__device__ __forceinline__ void prepass_preload(const Params& p, int item, u32x4 (&pr)[7], float (&pf)[5]) {
  int tid = threadIdx.x;
  asm volatile("" : "+v"(tid));
  const bool lat = item < 2048;
  int b, c, h;
  if (lat) { b = item >> 8; c = (item >> 2) & 63; h = item & 3; }
  else { int it = item - 2048; b = it >> 4; c = (it >> 2) & 3; h = it & 3; }
  const int Tseq = lat ? 4096 : 256;
  const bf16_t* PQKV = (const bf16_t*)(p.ws + OFF_PQKV);
  const float* PAB = (const float*)(p.ws + OFF_PAB);
#pragma unroll
  for (int i = 0; i < 7; ++i) {
    const int s = tid + i * NT;
    const int rr = s / 48, q = s % 48;
    const int part = q >> 4, sg = q & 15;
    const int j = c * 64 - 2 + rr;
    u32x4 val = {0u, 0u, 0u, 0u};
    if (s < 67 * 48 && j >= 0 && j < Tseq) {
      const size_t grow = lat ? (size_t)b * 4096 + (size_t)((j & 63) * 64 + (j >> 6)) : (size_t)RLAT + b * 256 + j;
      val = *(const u32x4*)(PQKV + grow * 1536 + part * 512 + h * 128 + sg * 8);
    }
    pr[i] = val;
  }
  pf[0] = 0.f;
}

__device__ __forceinline__ void gdn_prepass_item(const Params& p, int item, int next_item, unsigned char* smem, u32x4 (&pr)[7], float (&pf)[5]) {
  const int tid = threadIdx.x, lane = tid & 63, w = tid >> 6;
  const bool lat = item < 2048;
  int b, c, h;
  if (lat) { b = item >> 8; c = (item >> 2) & 63; h = item & 3; }
  else { int it = item - 2048; b = it >> 4; c = (it >> 2) & 3; h = it & 3; }
  const int Tseq = lat ? 4096 : 256;
  const bf16_t* PQKV = (const bf16_t*)(p.ws + OFF_PQKV);
  const float* PAB = (const float*)(p.ws + OFF_PAB);

  bf16_t* raw = (bf16_t*)smem;
  float* KK = (float*)smem;
  float* QK = KK + 64 * 68;
  bf16_t* qb = (bf16_t*)(smem + 51456);
  bf16_t* kb = qb + 64 * 136;
  float* vf = (float*)(smem + 51456 + 34816);
  float* Am = vf + 64 * 128;
  float* gcs = Am + 2 * 64 * 64;
  float* bet = gcs + 128;
  float* beg = bet + 128;

#pragma unroll
  for (int i = 0; i < 7; ++i) {
    const int s = tid + i * NT;
    if (s < 67 * 48) {
      const int rr = s / 48, q = s % 48;
      *(u32x4*)(raw + rr * 384 + (q >> 4) * 128 + (q & 15) * 8) = pr[i];
    }
  }
  for (int s = tid; s < 4 * 384; s += NT) {
    const int kk = s / 384, q = s % 384;
    Am[s] = p.gdn_conv_w[kk * 1536 + (q >> 7) * 512 + h * 128 + (q & 127)];
  }
  if (tid < 128) {
    const int dir = tid >> 6, i = tid & 63;
    const int tok = dir ? 63 - i : i;
    const int j = c * 64 + tok;
    const size_t grow = lat ? (size_t)b * 4096 + (size_t)((j & 63) * 64 + (j >> 6)) : (size_t)RLAT + b * 256 + j;
    const float a_ = PAB[grow * 16 + dir * 8 + h];
    const float b_ = PAB[grow * 16 + dir * 8 + 4 + h];
    float g = -__expf(p.gdn_a_log[dir * 4 + h]) * softplusf_(a_ + p.gdn_dt_bias[dir * 4 + h]);
    const float be = sigmoidf_(b_);
#pragma unroll
    for (int o = 1; o < 64; o <<= 1) {
      float t = __shfl_up(g, o, 64);
      if (lane >= o) g += t;
    }
    gcs[dir * 64 + i] = g;
    bet[dir * 64 + i] = be;
    beg[dir * 64 + i] = be * __expf(g);
  }
  __syncthreads();
  {
    float* cwL = Am;
    const int i = tid >> 3, sg = tid & 7;
#pragma unroll
    for (int part = 0; part < 3; ++part) {
      float y[16];
#pragma unroll
      for (int d = 0; d < 16; ++d) y[d] = 0.f;
#pragma unroll
      for (int kk = 0; kk < 4; ++kk) {
        const u32x4 r0 = *(const u32x4*)(raw + (i + kk) * 384 + part * 128 + sg * 16);
        const u32x4 r1 = *(const u32x4*)(raw + (i + kk) * 384 + part * 128 + sg * 16 + 8);
        const float* cwp = cwL + kk * 384 + part * 128 + sg * 16;
#pragma unroll
        for (int m = 0; m < 4; ++m) {
          const f32x4 w4 = *(const f32x4*)(cwp + 4 * m);
          const unsigned lo = (m < 2) ? r0[2 * m] : r1[2 * m - 4];
          const unsigned hi = (m < 2) ? r0[2 * m + 1] : r1[2 * m - 3];
          y[4 * m + 0] += w4[0] * __uint_as_float(lo << 16);
          y[4 * m + 1] += w4[1] * __uint_as_float(lo & 0xffff0000u);
          y[4 * m + 2] += w4[2] * __uint_as_float(hi << 16);
          y[4 * m + 3] += w4[3] * __uint_as_float(hi & 0xffff0000u);
        }
      }
      float ss = 0.f;
#pragma unroll
      for (int d = 0; d < 16; ++d) { y[d] = siluf_(y[d]); ss += y[d] * y[d]; }
      if (part < 2) {
        ss += __shfl_xor(ss, 1, 64);
        ss += __shfl_xor(ss, 2, 64);
        ss += __shfl_xor(ss, 4, 64);
        float scl = rsqrtf(ss + 1e-6f);
        if (part == 0) scl *= 0.08838834764831845f;
        bf16_t* dst = (part == 0 ? qb : kb) + i * 136 + sg * 16;
#pragma unroll
        for (int d = 0; d < 16; d += 2) *(unsigned*)(dst + d) = pack2(y[d] * scl, y[d + 1] * scl);
      } else {
#pragma unroll
        for (int d = 0; d < 16; ++d) vf[i * 128 + sg * 16 + d] = y[d];
      }
    }
  }
  __syncthreads();
  {
    const int which = w >> 2, tm = (w >> 1) & 1, tn = w & 1;
    const int r = lane & 31, hh = lane >> 5;
    const bf16_t* Ap = which ? qb : kb;
    f32x16 acc;
#pragma unroll
    for (int q = 0; q < 16; ++q) acc[q] = 0.f;
#pragma unroll
    for (int ks = 0; ks < 8; ++ks) {
      bf16x8 a = *(const bf16x8*)(Ap + (tm * 32 + r) * 136 + ks * 16 + hh * 8);
      bf16x8 bb = *(const bf16x8*)(kb + (tn * 32 + r) * 136 + ks * 16 + hh * 8);
      acc = MFMA32(a, bb, acc);
    }
    float* dst = which ? QK : KK;
#pragma unroll
    for (int q = 0; q < 16; ++q) {
      const int row = tm * 32 + (q & 3) + 8 * (q >> 2) + 4 * hh;
      dst[row * 68 + tn * 32 + r] = acc[q];
    }
  }
  __syncthreads();
  const int cidF = chunk_id(0, b, h, lat ? 4 + c : c);
  const int cidB = chunk_id(1, b, h, lat ? 4 + (63 - c) : 3 - c);
  {
    bf16_t* AT = (bf16_t*)((unsigned char*)p.out + OUT_AT);
    bf16_t* QG = (bf16_t*)(p.ws + OFF_QG);
    bf16_t* KDT = (bf16_t*)(p.ws + OFF_KDT);
    float* EGL = (float*)(p.ws + OFF_EGL);
    for (int e = tid; e < 2 * 64 * 64; e += NT) {
      const int dir = e >> 12, i = (e >> 6) & 63, s = e & 63;
      const int ti = dir ? 63 - i : i, ts = dir ? 63 - s : s;
      Am[e] = (i > s) ? bet[dir * 64 + i] * KK[ti * 68 + ts] * __expf(gcs[dir * 64 + i] - gcs[dir * 64 + s]) : 0.f;
    }
#pragma unroll 1
    for (int t = 0; t < 2; ++t) {
      const int e = tid + t * NT;
      const int dir = e >> 9, i = (e >> 3) & 63, s8 = e & 7;
      const int ti = dir ? 63 - i : i;
      const float gi = gcs[dir * 64 + i];
      float v[8];
#pragma unroll
      for (int k = 0; k < 8; ++k) {
        const int s = s8 * 8 + k;
        const int ts = dir ? 63 - s : s;
        v[k] = (i >= s) ? QK[ti * 68 + ts] * __expf(gi - gcs[dir * 64 + s]) : 0.f;
      }
      u32x4 o;
#pragma unroll
      for (int k = 0; k < 4; ++k) o[k] = pack2(v[2 * k], v[2 * k + 1]);
      *(u32x4*)(AT + (size_t)(dir ? cidB : cidF) * 4096 + i * 64 + s8 * 8) = o;
    }
#pragma unroll 1
    for (int t = 0; t < 4; ++t) {
      const int e = tid + t * NT;
      const int dir = e >> 10, i = (e >> 4) & 63, d8 = e & 15;
      const int ti = dir ? 63 - i : i;
      const float eg = __expf(gcs[dir * 64 + i]);
      const u32x4 qv = *(const u32x4*)(qb + ti * 136 + d8 * 8);
      u32x4 o;
#pragma unroll
      for (int k = 0; k < 4; ++k) o[k] = pack2(__uint_as_float(qv[k] << 16) * eg, __uint_as_float(qv[k] & 0xffff0000u) * eg);
      *(u32x4*)(QG + (size_t)(dir ? cidB : cidF) * 8192 + i * 128 + d8 * 8) = o;
    }
#pragma unroll 1
    for (int t = 0; t < 4; ++t) {
      const int e = tid + t * NT;
      const int dir = e >> 10, i8 = (e >> 7) & 7, d = e & 127;
      const float gl = gcs[dir * 64 + 63];
      float v[8];
#pragma unroll
      for (int k = 0; k < 8; ++k) {
        const int i = i8 * 8 + k;
        const int ti = dir ? 63 - i : i;
        v[k] = bf2f(kb[ti * 136 + d]) * __expf(gl - gcs[dir * 64 + i]);
      }
      u32x4 o;
#pragma unroll
      for (int k = 0; k < 4; ++k) o[k] = pack2(v[2 * k], v[2 * k + 1]);
      *(u32x4*)(KDT + (size_t)(dir ? cidB : cidF) * 8192 + d * 64 + i8 * 8) = o;
    }
    if (tid < 2) EGL[tid ? cidB : cidF] = __expf(gcs[tid * 64 + 63]);
  }
  __syncthreads();
  if (next_item < 2176) prepass_preload(p, next_item, pr, pf);
  {
    const int dir = tid >> 8, cidx = tid & 255;
    lds_b* sdst = (lds_b*)((bf16_t*)smem + (dir * 64) * 256 + cidx);
    if (dir == 0) {
      if (cidx < 128) solve_col<0, 0>((lds_cf*)Am, (lds_cf*)(vf + cidx), (lds_cb*)kb, (lds_cf*)bet, sdst);
      else solve_col<0, 1>((lds_cf*)Am, (lds_cf*)vf, (lds_cb*)(kb + (cidx - 128)), (lds_cf*)beg, sdst);
    } else {
      if (cidx < 128) solve_col<1, 0>((lds_cf*)(Am + 4096), (lds_cf*)(vf + cidx), (lds_cb*)kb, (lds_cf*)(bet + 64), sdst);
      else solve_col<1, 1>((lds_cf*)(Am + 4096), (lds_cf*)vf, (lds_cb*)(kb + (cidx - 128)), (lds_cf*)(beg + 64), sdst);
    }
  }
  __syncthreads();
  {
    bf16_t* WVg = (bf16_t*)((unsigned char*)p.out + OUT_WV);
    bf16_t* KCg = (bf16_t*)(p.ws + OFF_KC);
    const bf16_t* solL = (const bf16_t*)smem;
#pragma unroll 1
    for (int t = 0; t < 8; ++t) {
      const int e = tid + t * NT;
      const int dir = e >> 11, i = (e >> 5) & 63, sg = e & 31;
      const u32x4 v = *(const u32x4*)(solL + (dir * 64 + i) * 256 + sg * 8);
      bf16_t* dstp = (sg < 16) ? WVg + (size_t)(dir ? cidB : cidF) * 8192 + i * 128 + sg * 8
                               : KCg + (size_t)(dir ? cidB : cidF) * 8192 + i * 128 + (sg - 16) * 8;
      *(u32x4*)dstp = v;
    }
  }
  __syncthreads();
}

__device__ void gdn_seq_item(const Params& p, int item, unsigned char* smem) {
  const int tid = threadIdx.x, lane = tid & 63, w = tid >> 6;
  const int dvh = item & 1, h = (item >> 1) & 3, b = (item >> 3) & 7, dir = item >> 6;
  const bf16_t* KC = (const bf16_t*)(p.ws + OFF_KC);
  const bf16_t* QG = (const bf16_t*)(p.ws + OFF_QG);
  const bf16_t* KDT = (const bf16_t*)(p.ws + OFF_KDT);
  const bf16_t* WV = (const bf16_t*)((unsigned char*)p.out + OUT_WV);
  const bf16_t* AT = (const bf16_t*)((unsigned char*)p.out + OUT_AT);
  const float* EGL = (const float*)(p.ws + OFF_EGL);
  bf16_t* Odir = (bf16_t*)(p.ws + OFF_PQKV) + (size_t)dir * RLAT * 512;

  bf16_t* KCs = (bf16_t*)smem;
  bf16_t* QGs = KCs + 64 * 136;
  bf16_t* St = QGs + 64 * 136;
  bf16_t* ATs = St + 64 * 136;
  bf16_t* VnT = ATs + 64 * 72;
  bf16_t* WVs = VnT + 64 * 72;
  bf16_t* KDTs = WVs + 64 * 72;

  const int dkt = w >> 1, dvt = w & 1;
  const int r32 = lane & 31, h32 = lane >> 5;
  const int l15 = lane & 15, q4 = lane >> 4;
  const int tm = w >> 1, tn0 = (w & 1) * 2;
  f32x16 S;
#pragma unroll
  for (int q = 0; q < 16; ++q) S[q] = 0.f;
  for (int i = tid; i < 64 * 136 / 2; i += NT) ((unsigned*)St)[i] = 0u;

  const int cid0 = chunk_id(dir, b, h, 0);
  u32x4 rA[8], rB[8];
  float eglA, eglB;
#define SEQ_LOAD(R, EG, cid_)                                                                 \
  {                                                                                           \
    const size_t base_ = (size_t)(cid_) * 8192;                                               \
    R[0] = *(const u32x4*)(KC + base_ + tid * 8);                                             \
    R[1] = *(const u32x4*)(KC + base_ + (tid + 512) * 8);                                     \
    R[2] = *(const u32x4*)(QG + base_ + tid * 8);                                             \
    R[3] = *(const u32x4*)(QG + base_ + (tid + 512) * 8);                                     \
    R[4] = *(const u32x4*)(KDT + base_ + tid * 8);                                            \
    R[5] = *(const u32x4*)(KDT + base_ + (tid + 512) * 8);                                    \
    R[6] = *(const u32x4*)(AT + (size_t)(cid_) * 4096 + tid * 8);                             \
    R[7] = *(const u32x4*)(WV + base_ + (tid >> 3) * 128 + dvh * 64 + (tid & 7) * 8);        \
    EG = EGL[cid_];                                                                           \
  }
#define SEQ_STORE(R)                                                       \
  {                                                                        \
    *(u32x4*)(KCs + (tid >> 4) * 136 + (tid & 15) * 8) = R[0];             \
    *(u32x4*)(KCs + ((tid + 512) >> 4) * 136 + (tid & 15) * 8) = R[1];     \
    *(u32x4*)(QGs + (tid >> 4) * 136 + (tid & 15) * 8) = R[2];             \
    *(u32x4*)(QGs + ((tid + 512) >> 4) * 136 + (tid & 15) * 8) = R[3];     \
    *(u32x4*)(KDTs + (tid >> 3) * 72 + (tid & 7) * 8) = R[4];              \
    *(u32x4*)(KDTs + ((tid + 512) >> 3) * 72 + (tid & 7) * 8) = R[5];      \
    *(u32x4*)(ATs + (tid >> 3) * 72 + (tid & 7) * 8) = R[6];               \
    *(u32x4*)(WVs + (tid >> 3) * 72 + (tid & 7) * 8) = R[7];               \
  }
  auto compute = [&](const int ci, const float egl) __attribute__((always_inline)) {
    f32x4 accO[2];
#pragma unroll
    for (int t = 0; t < 2; ++t) {
      const int tn = tn0 + t;
      f32x4 accV = {0.f, 0.f, 0.f, 0.f};
      accO[t] = accV;
#pragma unroll
      for (int ks = 0; ks < 4; ++ks) {
        bf16x8 aK = *(const bf16x8*)(KCs + (tm * 16 + l15) * 136 + ks * 32 + q4 * 8);
        bf16x8 aQ = *(const bf16x8*)(QGs + (tm * 16 + l15) * 136 + ks * 32 + q4 * 8);
        bf16x8 bS = *(const bf16x8*)(St + (tn * 16 + l15) * 136 + ks * 32 + q4 * 8);
        accV = MFMA16(aK, bS, accV);
        accO[t] = MFMA16(aQ, bS, accO[t]);
      }
      float vn[4];
#pragma unroll
      for (int q = 0; q < 4; ++q) vn[q] = bf2f(WVs[(tm * 16 + q4 * 4 + q) * 72 + tn * 16 + l15]) - accV[q];
      uint2 pk;
      pk.x = pack2(vn[0], vn[1]);
      pk.y = pack2(vn[2], vn[3]);
      *(uint2*)(VnT + (tn * 16 + l15) * 72 + tm * 16 + q4 * 4) = pk;
    }
    __syncthreads();
#pragma unroll
    for (int t = 0; t < 2; ++t) {
      const int tn = tn0 + t;
#pragma unroll
      for (int ks = 0; ks < 2; ++ks) {
        bf16x8 aA = *(const bf16x8*)(ATs + (tm * 16 + l15) * 72 + ks * 32 + q4 * 8);
        bf16x8 bV = *(const bf16x8*)(VnT + (tn * 16 + l15) * 72 + ks * 32 + q4 * 8);
        accO[t] = MFMA16(aA, bV, accO[t]);
      }
      if (ci >= 4) {
#pragma unroll
        for (int q = 0; q < 4; ++q) {
          const int i = tm * 16 + q4 * 4 + q;
          const int sp = (ci - 4) * 64 + i;
          const int j = dir ? 4095 - sp : sp;
          const int t_r = (j & 63) * 64 + (j >> 6);
          Odir[((size_t)b * 4096 + t_r) * 512 + h * 128 + dvh * 64 + tn * 16 + l15] = f2bf(accO[t][q]);
        }
      }
    }
#pragma unroll
    for (int q = 0; q < 16; ++q) S[q] *= egl;
#pragma unroll
    for (int ks = 0; ks < 4; ++ks) {
      bf16x8 a = *(const bf16x8*)(KDTs + (dkt * 32 + r32) * 72 + ks * 16 + h32 * 8);
      bf16x8 bb = *(const bf16x8*)(VnT + (dvt * 32 + r32) * 72 + ks * 16 + h32 * 8);
      S = MFMA32(a, bb, S);
    }
#pragma unroll
    for (int g = 0; g < 4; ++g) {
      uint2 pk;
      pk.x = pack2(S[4 * g + 0], S[4 * g + 1]);
      pk.y = pack2(S[4 * g + 2], S[4 * g + 3]);
      *(uint2*)(St + (dvt * 32 + r32) * 136 + dkt * 32 + 8 * g + 4 * h32) = pk;
    }
    __syncthreads();
  };
  SEQ_LOAD(rA, eglA, cid0)
  SEQ_LOAD(rB, eglB, cid0 + 1)
  for (int ci = 0; ci < 68; ci += 2) {
    SEQ_STORE(rA)
    const float e0 = eglA;
    __syncthreads();
    if (ci + 2 < 68) SEQ_LOAD(rA, eglA, cid0 + ci + 2)
    compute(ci, e0);
    SEQ_STORE(rB)
    const float e1 = eglB;
    __syncthreads();
    if (ci + 3 < 68) SEQ_LOAD(rB, eglB, cid0 + ci + 3)
    compute(ci + 1, e1);
  }
#undef SEQ_LOAD
#undef SEQ_STORE
}

__device__ __forceinline__ float neg_expm1(float y) {
  return (y > -0.02f) ? -(y + 0.5f * y * y + (1.f / 6.f) * y * y * y) : 1.f - __expf(y);
}
__device__ void rglru_item(const Params& p, int it, unsigned char* smem) {
  const int tid = threadIdx.x, lane = tid & 63, w = tid >> 6;
  const int n = it & 7, b = (it >> 3) & 7, dir = it >> 6;
  const bf16_t* PRG = (const bf16_t*)(p.ws + OFF_PRG);
  bf16_t* Hdir = (bf16_t*)(p.ws + OFF_H) + (size_t)dir * RLAT * 512;
  bf16_t* ur = (bf16_t*)smem;
  bf16_t* xcb = ur + 132 * 72;
  bf16_t* wgt = xcb + 128 * 72;
  float* aL = (float*)(smem + (132 + 128 + 128) * 72 * 2);
  float* bL = aL + 128 * 64;
  float* segA = bL + 128 * 64;
  float* segB = segA + 512;
  for (int i = tid; i < 2 * 64 * 64; i += NT) {
    const int g = i >> 12, d = (i >> 6) & 63, e = i & 63;
    wgt[(g * 64 + e) * 72 + d] = f2bf(p.rg_gate_w[((((size_t)dir * 2 + g) * 8 + n) * 64 + d) * 64 + e]);
  }
  float* cwL = segB + 512;
  if (tid < 320) {
    const int kk = tid >> 6, e = tid & 63;
    cwL[tid] = (kk < 4) ? p.rg_conv_w[kk * 512 + n * 64 + e] : p.rg_conv_b[n * 64 + e];
  }
  const int cseg = tid & 7;
  const int tt = w >> 1, et = w & 1, r32 = lane & 31, h32 = lane >> 5;
  const int eg = et * 32 + r32;
  const float bias_r = p.rg_gate_b[(dir * 2 + 0) * 512 + n * 64 + eg];
  const float bias_i = p.rg_gate_b[(dir * 2 + 1) * 512 + n * 64 + eg];
  const float sp8 = -8.f * softplusf_(-p.rg_lambda[dir * 512 + n * 64 + eg]);
  float hstate = 0.f;
  u32x4 pu0, pu1, pu2;
#define RG_LOAD(tile_)                                                                           \
  {                                                                                              \
    const bool lat_ = (tile_) >= 2;                                                              \
    const int tl_ = lat_ ? (tile_) - 2 : (tile_);                                                \
    const int ntl_ = lat_ ? 32 : 2;                                                              \
    const int t0_ = (dir ? (ntl_ - 1 - tl_) : tl_) * 128;                                        \
    const int Tseq_ = lat_ ? 4096 : 256;                                                         \
    const size_t rbase_ = lat_ ? (size_t)b * 4096 : (size_t)RLAT + b * 256;                      \
    const u32x4 z_ = {0u, 0u, 0u, 0u};                                                           \
    { const int s_ = tid; const int t_ = t0_ - 2 + (s_ >> 3);                                   \
      pu0 = (t_ >= 0 && t_ < Tseq_) ? *(const u32x4*)(PRG + (rbase_ + t_) * 1024 + n * 64 + (s_ & 7) * 8) : z_; } \
    { const int s_ = tid + 512; const int t_ = t0_ - 2 + (s_ >> 3);                             \
      pu1 = (t_ >= 0 && t_ < Tseq_) ? *(const u32x4*)(PRG + (rbase_ + t_) * 1024 + n * 64 + (s_ & 7) * 8) : z_; } \
    { const int s_ = tid + 1024; const int t_ = t0_ - 2 + (s_ >> 3);                            \
      pu2 = (s_ < 1048 && t_ >= 0 && t_ < Tseq_) ? *(const u32x4*)(PRG + (rbase_ + t_) * 1024 + n * 64 + (s_ & 7) * 8) : z_; } \
  }
  RG_LOAD(0)
  for (int tile = 0; tile < 34; ++tile) {
    const bool lat = tile >= 2;
    const int tl = lat ? tile - 2 : tile;
    const int ntl = lat ? 32 : 2;
    const int t0 = (dir ? (ntl - 1 - tl) : tl) * 128;
    *(u32x4*)(ur + (tid >> 3) * 72 + (tid & 7) * 8) = pu0;
    *(u32x4*)(ur + ((tid + 512) >> 3) * 72 + (tid & 7) * 8) = pu1;
    if (tid + 1024 < 1048) *(u32x4*)(ur + ((tid + 1024) >> 3) * 72 + (tid & 7) * 8) = pu2;
    __syncthreads();
    if (tile + 1 < 34) RG_LOAD(tile + 1)
#pragma unroll
    for (int half = 0; half < 2; ++half) {
      const int tok = (tid >> 3) + half * 64;
      float a[8];
      {
        const f32x4 c0 = *(const f32x4*)(cwL + 256 + cseg * 8), c1 = *(const f32x4*)(cwL + 256 + cseg * 8 + 4);
#pragma unroll
        for (int j = 0; j < 4; ++j) { a[j] = c0[j]; a[4 + j] = c1[j]; }
      }
#pragma unroll
      for (int kk = 0; kk < 4; ++kk) {
        const u32x4 uv = *(const u32x4*)(ur + (tok + kk) * 72 + cseg * 8);
        const f32x4 w0 = *(const f32x4*)(cwL + kk * 64 + cseg * 8), w1 = *(const f32x4*)(cwL + kk * 64 + cseg * 8 + 4);
        a[0] += w0[0] * __uint_as_float(uv[0] << 16);
        a[1] += w0[1] * __uint_as_float(uv[0] & 0xffff0000u);
        a[2] += w0[2] * __uint_as_float(uv[1] << 16);
        a[3] += w0[3] * __uint_as_float(uv[1] & 0xffff0000u);
        a[4] += w1[0] * __uint_as_float(uv[2] << 16);
        a[5] += w1[1] * __uint_as_float(uv[2] & 0xffff0000u);
        a[6] += w1[2] * __uint_as_float(uv[3] << 16);
        a[7] += w1[3] * __uint_as_float(uv[3] & 0xffff0000u);
      }
      u32x4 o;
#pragma unroll
      for (int m = 0; m < 4; ++m) o[m] = pack2(a[2 * m], a[2 * m + 1]);
      *(u32x4*)(xcb + tok * 72 + cseg * 8) = o;
    }
    __syncthreads();
    {
      f32x16 accR, accI;
#pragma unroll
      for (int q = 0; q < 16; ++q) { accR[q] = 0.f; accI[q] = 0.f; }
#pragma unroll
      for (int ks = 0; ks < 4; ++ks) {
        bf16x8 a = *(const bf16x8*)(xcb + (tt * 32 + r32) * 72 + ks * 16 + h32 * 8);
        bf16x8 br = *(const bf16x8*)(wgt + (et * 32 + r32) * 72 + ks * 16 + h32 * 8);
        bf16x8 bi = *(const bf16x8*)(wgt + (64 + et * 32 + r32) * 72 + ks * 16 + h32 * 8);
        accR = MFMA32(a, br, accR);
        accI = MFMA32(a, bi, accI);
      }
#pragma unroll
      for (int q = 0; q < 16; ++q) {
        const int tok = tt * 32 + (q & 3) + 8 * (q >> 2) + 4 * h32;
        const float er = __expf(-(accR[q] + bias_r)), ei = __expf(-(accI[q] + bias_i));
        const float dr = 1.f + er, di = 1.f + ei;
        const float inv = __frcp_rn(dr * di);
        const float rr = inv * di, ii = inv * dr;
        const float log_a = sp8 * rr;
        const float av = __expf(log_a);
        const float y = -2.f * log_a;
        const float om = (y < 0.04f) ? y * (1.f - y * (0.5f - y * (1.f / 6.f - y * (1.f / 24.f)))) : 1.f - av * av;
        const float xv = bf2f(xcb[tok * 72 + eg]);
        aL[tok * 64 + eg] = av;
        bL[tok * 64 + eg] = __builtin_amdgcn_sqrtf(om) * (ii * xv);
      }
    }
    __syncthreads();
    float Pk[16], Hk[16];
    {
      float P = 1.f, hl = 0.f;
#pragma unroll
      for (int k = 0; k < 16; ++k) {
        const int s = 16 * w + k;
        const int tok = dir ? 127 - s : s;
        const float av = aL[tok * 64 + lane], bv = bL[tok * 64 + lane];
        hl = av * hl + bv;
        P = P * av;
        Pk[k] = P;
        Hk[k] = hl;
      }
      segA[w * 64 + lane] = P;
      segB[w * 64 + lane] = hl;
    }
    __syncthreads();
    {
      float hin = hstate, my_in = 0.f;
#pragma unroll
      for (int ww = 0; ww < 8; ++ww) {
        if (ww == w) my_in = hin;
        hin = segA[ww * 64 + lane] * hin + segB[ww * 64 + lane];
      }
      hstate = hin;
      if (lat) {
#pragma unroll
        for (int k = 0; k < 16; ++k) {
          const int s = 16 * w + k;
          const int tok = dir ? 127 - s : s;
          Hdir[((size_t)b * 4096 + t0 + tok) * 512 + n * 64 + lane] = f2bf(Pk[k] * my_in + Hk[k]);
        }
      }
    }
  }
  __syncthreads();
#undef RG_LOAD
}

__device__ void phase_ya(const Params& p) {
  const int lane = threadIdx.x & 63, w = threadIdx.x >> 6;
  const bf16_t* PRG = (const bf16_t*)(p.ws + OFF_PRG);
  const bf16_t* PZ = (const bf16_t*)(p.ws + OFF_PZ);
  const bf16_t* HF = (const bf16_t*)(p.ws + OFF_H);
  const bf16_t* HB = HF + (size_t)RLAT * 512;
  const bf16_t* OF = (const bf16_t*)(p.ws + OFF_PQKV);
  const bf16_t* OB = OF + (size_t)RLAT * 512;
  bf16_t* YA = (bf16_t*)(p.ws + OFF_QG);
  for (int row = blockIdx.x * 8 + w; row < RLAT; row += gridDim.x * 8) {
    const int c0 = lane * 8;
    uint4 hf = *(const uint4*)(HF + (size_t)row * 512 + c0);
    uint4 hb = *(const uint4*)(HB + (size_t)row * 512 + c0);
    uint4 gt = *(const uint4*)(PRG + (size_t)row * 1024 + 512 + c0);
    uint4 of = *(const uint4*)(OF + (size_t)row * 512 + c0);
    uint4 ob = *(const uint4*)(OB + (size_t)row * 512 + c0);
    uint4 zz = *(const uint4*)(PZ + (size_t)row * 512 + c0);
    const unsigned* hfp = (const unsigned*)&hf; const unsigned* hbp = (const unsigned*)&hb;
    const unsigned* gtp = (const unsigned*)&gt; const unsigned* ofp = (const unsigned*)&of;
    const unsigned* obp = (const unsigned*)&ob; const unsigned* zzp = (const unsigned*)&zz;
    float y[8], o[8], z[8];
    float ss = 0.f;
#pragma unroll
    for (int q = 0; q < 4; ++q) {
      float hf0 = bf2f((bf16_t)(hfp[q] & 0xffff)), hf1 = bf2f((bf16_t)(hfp[q] >> 16));
      float hb0 = bf2f((bf16_t)(hbp[q] & 0xffff)), hb1 = bf2f((bf16_t)(hbp[q] >> 16));
      float g0 = bf2f((bf16_t)(gtp[q] & 0xffff)), g1 = bf2f((bf16_t)(gtp[q] >> 16));
      y[2 * q] = (hf0 + hb0) * gelu_tanh(g0);
      y[2 * q + 1] = (hf1 + hb1) * gelu_tanh(g1);
      o[2 * q] = bf2f((bf16_t)(ofp[q] & 0xffff)) + bf2f((bf16_t)(obp[q] & 0xffff));
      o[2 * q + 1] = bf2f((bf16_t)(ofp[q] >> 16)) + bf2f((bf16_t)(obp[q] >> 16));
      z[2 * q] = bf2f((bf16_t)(zzp[q] & 0xffff));
      z[2 * q + 1] = bf2f((bf16_t)(zzp[q] >> 16));
      ss += o[2 * q] * o[2 * q] + o[2 * q + 1] * o[2 * q + 1];
    }
    ss += __shfl_xor(ss, 1, 64);
    ss += __shfl_xor(ss, 2, 64);
    ss += __shfl_xor(ss, 4, 64);
    ss += __shfl_xor(ss, 8, 64);
    const float rstd = rsqrtf(ss * (1.f / 128.f) + 1e-6f);
    const int d0 = (lane & 15) * 8;
    uint4 o1, o2;
    unsigned* o1p = (unsigned*)&o1; unsigned* o2p = (unsigned*)&o2;
#pragma unroll
    for (int q = 0; q < 4; ++q) {
      o1p[q] = pack2(y[2 * q], y[2 * q + 1]);
      float a0 = o[2 * q] * rstd * p.gdn_norm_g[d0 + 2 * q] * siluf_(z[2 * q]);
      float a1 = o[2 * q + 1] * rstd * p.gdn_norm_g[d0 + 2 * q + 1] * siluf_(z[2 * q + 1]);
      o2p[q] = pack2(a0, a1);
    }
    *(uint4*)(YA + (size_t)row * 1024 + c0) = o1;
    *(uint4*)(YA + (size_t)row * 1024 + 512 + c0) = o2;
  }
}

__device__ void phase_outproj(const Params& p, unsigned char* smem) {
  const bf16_t* YA = (const bf16_t*)(p.ws + OFF_QG);
  const bf16_t* WT = (const bf16_t*)(p.ws + OFF_WOUT);
  const float* mod = (const float*)(p.ws + OFF_MOD);
  const int lane = threadIdx.x & 63, w = threadIdx.x >> 6;
  const int wm = w >> 2, wn = w & 3, r = lane & 31, h = lane >> 5;
  const bool swz = (gridDim.x == 256);
  const int xcd = blockIdx.x & 7;
  const int ntiles = swz ? 16 * 4 : 128 * 4;
  for (int k = swz ? (blockIdx.x >> 3) : blockIdx.x; k < ntiles; k += swz ? 32 : gridDim.x) {
    const int mt = swz ? xcd + 8 * (k >> 2) : (k >> 2), nt = k & 3;
    const int m0 = mt * 256, n0 = nt * 256;
    f32x16 acc[4][2];
    gemm_tile256(YA + (size_t)m0 * 1024, WT + (size_t)n0 * 1024, acc, smem);
    const int bb = m0 >> 12;
    float* Cf = (float*)(smem + w * 8704);
#pragma unroll
    for (int i = 0; i < 4; ++i) {
#pragma unroll
      for (int j = 0; j < 2; ++j)
#pragma unroll
        for (int q = 0; q < 16; ++q) Cf[((q & 3) + 8 * (q >> 2) + 4 * h) * 68 + j * 32 + r] = acc[i][j][q];
#pragma unroll
      for (int it = 0; it < 8; ++it) {
        const int row = (lane >> 4) + 4 * it, seg = lane & 15;
        const f32x4 av = *(const f32x4*)(Cf + row * 68 + seg * 4);
        const size_t grow = m0 + wm * 128 + i * 32 + row;
        const int n = n0 + wn * 64 + seg * 4;
        const f32x4 xv = *(const f32x4*)(p.x + grow * 1024 + n);
        const f32x4 gv = *(const f32x4*)(mod + bb * 6144 + 2048 + n);
        f32x4 o;
        o[0] = xv[0] + gv[0] * av[0]; o[1] = xv[1] + gv[1] * av[1]; o[2] = xv[2] + gv[2] * av[2]; o[3] = xv[3] + gv[3] * av[3];
        *(f32x4*)(p.out + grow * 1024 + n) = o;
      }
    }
  }
}

#define INS16(list, val)                       \
  {                                            \
    float nv_ = (val);                         \
    _Pragma("unroll") for (int k_ = 0; k_ < 16; ++k_) { \
      float hi_ = fmaxf(list[k_], nv_);        \
      nv_ = fminf(list[k_], nv_);              \
      list[k_] = hi_;                          \
    }                                          \
  }

__device__ __forceinline__ void cswap_desc(float& a, float& b) {
  const float hi = fmaxf(a, b), lo = fminf(a, b);
  a = hi;
  b = lo;
}
__device__ __forceinline__ void bitonic_sort16_desc(float (&a)[16]) {
#pragma unroll
  for (int k = 2; k <= 16; k <<= 1)
#pragma unroll
    for (int j = k >> 1; j > 0; j >>= 1)
#pragma unroll
      for (int i = 0; i < 16; ++i) {
        const int l = i ^ j;
        if (l > i) {
          if ((i & k) == 0) cswap_desc(a[i], a[l]);
          else cswap_desc(a[l], a[i]);
        }
      }
}
__device__ __forceinline__ void merge_top16_desc(float (&a)[16], const float (&b)[16]) {
#pragma unroll
  for (int i = 0; i < 16; ++i) a[i] = fmaxf(a[i], b[15 - i]);
#pragma unroll
  for (int j = 8; j > 0; j >>= 1)
#pragma unroll
    for (int i = 0; i < 16; ++i) {
      const int l = i ^ j;
      if (l > i) cswap_desc(a[i], a[l]);
    }
}

__device__ void phase_peer_query(const Params& p, unsigned char* smem) {
  const bf16_t* H2 = (const bf16_t*)(p.ws + OFF_PRG);
  const bf16_t* WT = (const bf16_t*)(p.ws + OFF_WQ);
  const bf16_t* KEYS = (const bf16_t*)(p.ws + OFF_KEYS);
  float* LISTS = (float*)(p.ws + OFF_PZ);
  bf16_t* Qs = (bf16_t*)smem;
  bf16_t* Ks = (bf16_t*)(smem + 69632);
  const int tid = threadIdx.x, lane = tid & 63, w = tid >> 6;
  const int wm = w >> 1, wn = w & 1, r = lane & 31, h = lane >> 5;
  const bool swz = (gridDim.x == 256);
  const int xcd = blockIdx.x & 7;
  const int ntiles = swz ? 16 * 16 : 128 * 16;
  for (int k = swz ? (blockIdx.x >> 3) : blockIdx.x; k < ntiles; k += swz ? 32 : gridDim.x) {
    int mt, hx;
    if (!swz) { mt = k >> 4; hx = k & 15; }
    else { const int g = k >> 7, kk = k & 127; mt = xcd + 8 * (kk >> 3); hx = g * 8 + (kk & 7); }
    const int m0 = mt * 256, n0 = hx * 128;
    const int xh = hx & 1;
    f32x16 acc[2][2];
    gemm_tile(H2 + (size_t)m0 * 1024, WT + (size_t)n0 * 1024, acc, smem);
#pragma unroll
    for (int i = 0; i < 2; ++i)
#pragma unroll
      for (int j = 0; j < 2; ++j)
#pragma unroll
        for (int q = 0; q < 16; ++q) {
          const int row = wm * 64 + i * 32 + (q & 3) + 8 * (q >> 2) + 4 * h;
          const int col = wn * 64 + j * 32 + r;
          Qs[row * 136 + col] = f2bf(acc[i][j][q]);
        }
#pragma unroll
    for (int i = 0; i < 4; ++i) {
      int seg = tid + 512 * i;
      *(uint4*)(Ks + (seg >> 4) * 136 + (seg & 15) * 8) = *(const uint4*)(KEYS + (size_t)xh * 16384 + seg * 8);
    }
    __syncthreads();
    f32x16 sc[4];
#pragma unroll
    for (int m4 = 0; m4 < 4; ++m4)
#pragma unroll
      for (int q = 0; q < 16; ++q) sc[m4][q] = 0.f;
#pragma unroll
    for (int ks = 0; ks < 8; ++ks) {
      bf16x8 bq = *(const bf16x8*)(Qs + (w * 32 + r) * 136 + ks * 16 + h * 8);
#pragma unroll
      for (int m4 = 0; m4 < 4; ++m4) {
        bf16x8 ak = *(const bf16x8*)(Ks + (m4 * 32 + r) * 136 + ks * 16 + h * 8);
        sc[m4] = MFMA32(ak, bq, sc[m4]);
      }
    }
    float list[16];
#pragma unroll
    for (int m4 = 0; m4 < 4; ++m4) {
      float t[16];
#pragma unroll
      for (int q = 0; q < 16; ++q) {
        const unsigned kidx = (unsigned)(m4 * 32 + (q & 3) + 8 * (q >> 2)) | ((unsigned)h << 2);
        t[q] = __uint_as_float((__float_as_uint(sc[m4][q]) & ~127u) | kidx);
      }
      bitonic_sort16_desc(t);
      if (m4 == 0) {
#pragma unroll
        for (int q = 0; q < 16; ++q) list[q] = t[q];
      } else {
        merge_top16_desc(list, t);
      }
    }
    {
      float other[16];
#pragma unroll
      for (int k = 0; k < 16; ++k) other[k] = __shfl_xor(list[k], 32, 64);
      merge_top16_desc(list, other);
    }
    if (h == 0) {
      const size_t tok = (size_t)m0 + w * 32 + r;
      float4* dst = (float4*)(LISTS + (tok * 16 + hx) * 16);
#pragma unroll
      for (int k = 0; k < 4; ++k) dst[k] = make_float4(list[4 * k], list[4 * k + 1], list[4 * k + 2], list[4 * k + 3]);
    }
    __syncthreads();
  }
}

constexpr size_t OFF_UQ = OFF_KDT;
constexpr size_t OFF_VQ = OFF_KDT + 16777216;
constexpr size_t OFF_SUV = OFF_KC;
constexpr size_t OFF_PD = OFF_KC + 1048576;
constexpr size_t OFF_SELE = OFF_PQKV;
constexpr size_t OFF_SELG = OFF_PQKV + 16777216;
constexpr size_t OFF_HQ = OFF_PQKV + 33554432;
constexpr size_t OFF_HSC = OFF_PQKV + 67108864;
constexpr size_t OFF_CQ = OFF_PQKV + 68157440;
constexpr size_t OFF_CSC = OFF_PQKV + 72351744;
constexpr size_t OFF_SS = OFF_PQKV + 73400320;
__device__ void phase_quant_uv(const Params& p) {
  const int lane = threadIdx.x & 63, w = threadIdx.x >> 6;
  float* SC = (float*)(p.ws + OFF_SUV);
  for (int row = blockIdx.x * 8 + w; row < 32768; row += gridDim.x * 8) {
    const float* src = (row < 16384 ? p.peer_u : p.peer_v) + (size_t)(row & 16383) * 1024 + lane * 16;
    float4 v[4];
    float am = 0.f;
#pragma unroll
    for (int m = 0; m < 4; ++m) {
      v[m] = ((const float4*)src)[m];
      am = fmaxf(am, fmaxf(fmaxf(fabsf(v[m].x), fabsf(v[m].y)), fmaxf(fabsf(v[m].z), fabsf(v[m].w))));
    }
#pragma unroll
    for (int o = 32; o > 0; o >>= 1) am = fmaxf(am, __shfl_xor(am, o, 64));
    am = fmaxf(am, 1e-30f);
    const float inv = 127.f / am;
    u32x4 pk;
#pragma unroll
    for (int m = 0; m < 4; ++m) {
      const unsigned q0 = (unsigned)((int)rintf(v[m].x * inv)) & 255u;
      const unsigned q1 = (unsigned)((int)rintf(v[m].y * inv)) & 255u;
      const unsigned q2 = (unsigned)((int)rintf(v[m].z * inv)) & 255u;
      const unsigned q3 = (unsigned)((int)rintf(v[m].w * inv)) & 255u;
      pk[m] = q0 | (q1 << 8) | (q2 << 16) | (q3 << 24);
    }
    unsigned char* base = p.ws + (row < 16384 ? OFF_UQ : OFF_VQ);
    *(u32x4*)(base + (size_t)(lane >> 3) * 2097152 + (size_t)(row & 16383) * 128 + (lane & 7) * 16) = pk;
    if (lane == 0) SC[row] = am * (1.f / 127.f);
  }
}

__device__ void phase_peer_select(const Params& p, unsigned char* smem) {
  const int tid = threadIdx.x, lane = tid & 63, w = tid >> 6;
  const float* LISTS = (const float*)(p.ws + OFF_PZ);
  unsigned short* SELE = (unsigned short*)(p.ws + OFF_SELE);
  float* SELG = (float*)(p.ws + OFF_SELG);
  int* tab = (int*)smem + tid * 33;
  for (int base = (blockIdx.x * 8 + w) * 8; base < RLAT; base += gridDim.x * 64) {
    const int tok = base + (lane >> 3), hh = lane & 7;
    float s1[16], s2[16];
    const float4* l1 = (const float4*)(LISTS + ((size_t)tok * 16 + hh * 2) * 16);
#pragma unroll
    for (int k = 0; k < 4; ++k) {
      float4 a = l1[k], c2 = l1[4 + k];
      s1[4 * k] = a.x; s1[4 * k + 1] = a.y; s1[4 * k + 2] = a.z; s1[4 * k + 3] = a.w;
      s2[4 * k] = c2.x; s2[4 * k + 1] = c2.y; s2[4 * k + 2] = c2.z; s2[4 * k + 3] = c2.w;
    }
#pragma unroll
    for (int k = 0; k < 16; ++k) {
      tab[k] = (int)(__float_as_uint(s1[k]) & 127u);
      tab[16 + k] = (int)(__float_as_uint(s2[k]) & 127u);
      s1[k] = __uint_as_float(__float_as_uint(s1[k]) & ~127u);
      s2[k] = __uint_as_float(__float_as_uint(s2[k]) & ~127u);
    }
    float list[16];
#pragma unroll
    for (int k = 0; k < 16; ++k) list[k] = -3.0e38f;
#pragma unroll
    for (int i = 0; i < 16; ++i)
#pragma unroll
      for (int j = 0; j < 16; ++j)
        if ((i + 1) * (j + 1) <= 16) {
          const float cs = s1[i] + s2[j];
          const float v = __uint_as_float((__float_as_uint(cs) & ~255u) | (unsigned)(i * 16 + j));
          INS16(list, v);
        }
    float ex[16], sum = 0.f;
#pragma unroll
    for (int k = 0; k < 16; ++k) { ex[k] = __expf(list[k] - list[0]); sum += ex[k]; }
    const float inv = 1.f / sum;
#pragma unroll
    for (int k = 0; k < 16; ++k) {
      const unsigned bits = __float_as_uint(list[k]);
      const int i = (bits >> 4) & 15, j = bits & 15;
      const int idx = hh * 16 + k;
      const int pos = (idx & 7) * 16 + (idx >> 3);
      SELE[(size_t)tok * 128 + pos] = (unsigned short)(tab[i] * 128 + tab[16 + j]);
      SELG[(size_t)tok * 128 + pos] = ex[k] * inv;
    }
  }
  {
    const bf16_t* H2 = (const bf16_t*)(p.ws + OFF_PRG);
    float* HSC = (float*)(p.ws + OFF_HSC);
    for (int tok = blockIdx.x * 8 + w; tok < RLAT; tok += gridDim.x * 8) {
      const u32x4 a = *(const u32x4*)(H2 + (size_t)tok * 1024 + lane * 16);
      const u32x4 b = *(const u32x4*)(H2 + (size_t)tok * 1024 + lane * 16 + 8);
      float v[16];
#pragma unroll
      for (int m = 0; m < 4; ++m) {
        v[2 * m] = __uint_as_float(a[m] << 16); v[2 * m + 1] = __uint_as_float(a[m] & 0xffff0000u);
        v[8 + 2 * m] = __uint_as_float(b[m] << 16); v[8 + 2 * m + 1] = __uint_as_float(b[m] & 0xffff0000u);
      }
      float am = 0.f;
#pragma unroll
      for (int j = 0; j < 16; ++j) am = fmaxf(am, fabsf(v[j]));
#pragma unroll
      for (int o = 32; o > 0; o >>= 1) am = fmaxf(am, __shfl_xor(am, o, 64));
      am = fmaxf(am, 1e-30f);
      const float inv = 127.f / am;
      u32x4 pk;
#pragma unroll
      for (int m = 0; m < 4; ++m) {
        const unsigned q0 = (unsigned)((int)rintf(v[4 * m] * inv)) & 255u;
        const unsigned q1 = (unsigned)((int)rintf(v[4 * m + 1] * inv)) & 255u;
        const unsigned q2 = (unsigned)((int)rintf(v[4 * m + 2] * inv)) & 255u;
        const unsigned q3 = (unsigned)((int)rintf(v[4 * m + 3] * inv)) & 255u;
        pk[m] = q0 | (q1 << 8) | (q2 << 16) | (q3 << 24);
      }
      *(u32x4*)(p.ws + OFF_HQ + (size_t)tok * 1024 + lane * 16) = pk;
      if (lane == 0) HSC[tok] = am * (1.f / 127.f);
    }
  }
}

__device__ void phase_peer_udot(const Params& p) {
  const int lane = threadIdx.x & 63, w = threadIdx.x >> 6;
  const int g = lane >> 3, part = lane & 7;
  const unsigned short* SELE = (const unsigned short*)(p.ws + OFF_SELE);
  short* PD = (short*)(p.ws + OFF_PD);
  for (int item = blockIdx.x; item < 256; item += gridDim.x) {
    const int x = item & 7, lb = item >> 3;
    const unsigned char* US = p.ws + OFF_UQ + (size_t)x * 2097152 + part * 16;
    for (int t = 0; t < 128; ++t) {
      const int tok = lb * 1024 + w * 128 + t;
      const u32x4 hq = *(const u32x4*)(p.ws + OFF_HQ + (size_t)tok * 1024 + x * 128 + part * 16);
      int eid[16];
#pragma unroll
      for (int m = 0; m < 2; ++m) {
        const u32x4 e4 = *(const u32x4*)(SELE + (size_t)tok * 128 + g * 16 + m * 8);
#pragma unroll
        for (int q = 0; q < 4; ++q) { eid[8 * m + 2 * q] = (int)(e4[q] & 0xffffu); eid[8 * m + 2 * q + 1] = (int)(e4[q] >> 16); }
      }
      u32x4 uq[16];
#pragma unroll
      for (int it = 0; it < 16; ++it) uq[it] = *(const u32x4*)(US + (size_t)eid[it] * 128);
      int d0 = 0, d1 = 0;
#pragma unroll
      for (int it = 0; it < 16; ++it) {
        int d = __builtin_amdgcn_sdot4((int)uq[it][0], (int)hq[0], 0, false);
        d = __builtin_amdgcn_sdot4((int)uq[it][1], (int)hq[1], d, false);
        d = __builtin_amdgcn_sdot4((int)uq[it][2], (int)hq[2], d, false);
        d = __builtin_amdgcn_sdot4((int)uq[it][3], (int)hq[3], d, false);
        d += __builtin_amdgcn_update_dpp(0, d, 0xB1, 0xf, 0xf, false);
        d += __builtin_amdgcn_update_dpp(0, d, 0x4E, 0xf, 0xf, false);
        d += __builtin_amdgcn_update_dpp(0, d, 0x141, 0xf, 0xf, false);
        if (it < 8) { if (part == it) d0 = d; } else { if (part == it - 8) d1 = d; }
      }
      short* dst = PD + ((size_t)x * 32768 + tok) * 128 + g * 16 + part;
      dst[0] = (short)((d0 + 32) >> 6);
      dst[8] = (short)((d1 + 32) >> 6);
    }
  }
}

__device__ void phase_peer_coef(const Params& p) {
  const int lane = threadIdx.x & 63, w = threadIdx.x >> 6;
  const unsigned short* SELE = (const unsigned short*)(p.ws + OFF_SELE);
  const float* SELG = (const float*)(p.ws + OFF_SELG);
  const short* PD = (const short*)(p.ws + OFF_PD);
  const float* SU = (const float*)(p.ws + OFF_SUV);
  const float* SV = SU + 16384;
  const float* HSC = (const float*)(p.ws + OFF_HSC);
  unsigned char* CQ = p.ws + OFF_CQ;
  float* CSC = (float*)(p.ws + OFF_CSC);
  for (int tok0 = (blockIdx.x * 8 + w) * 4; tok0 < RLAT; tok0 += gridDim.x * 32) {
    int e[4][2], ds[4][2];
    float gt[4][2], hs[4];
#pragma unroll
    for (int tt = 0; tt < 4; ++tt) {
      const int tok = tok0 + tt;
      hs[tt] = HSC[tok];
#pragma unroll
      for (int q = 0; q < 2; ++q) {
        const int pos = lane + 64 * q;
        e[tt][q] = (int)SELE[(size_t)tok * 128 + pos];
        gt[tt][q] = SELG[(size_t)tok * 128 + pos];
        int s = 0;
#pragma unroll
        for (int x = 0; x < 8; ++x) s += (int)PD[((size_t)x * 32768 + tok) * 128 + pos];
        ds[tt][q] = s * 64;
      }
    }
    float su[4][2], sv[4][2];
#pragma unroll
    for (int tt = 0; tt < 4; ++tt)
#pragma unroll
      for (int q = 0; q < 2; ++q) { su[tt][q] = SU[e[tt][q]]; sv[tt][q] = SV[e[tt][q]]; }
#pragma unroll
    for (int tt = 0; tt < 4; ++tt) {
      const int tok = tok0 + tt;
      float coef[2];
#pragma unroll
      for (int q = 0; q < 2; ++q) {
        const float dot = su[tt][q] * hs[tt] * (float)ds[tt][q];
        coef[q] = gt[tt][q] * gelu_tanh(dot) * sv[tt][q];
      }
      float am = fmaxf(fabsf(coef[0]), fabsf(coef[1]));
#pragma unroll
      for (int o = 32; o > 0; o >>= 1) am = fmaxf(am, __shfl_xor(am, o, 64));
      am = fmaxf(am, 1e-30f);
      const float inv = 127.f / am;
      CQ[(size_t)tok * 128 + lane] = (unsigned char)((int)rintf(coef[0] * inv) & 255);
      CQ[(size_t)tok * 128 + 64 + lane] = (unsigned char)((int)rintf(coef[1] * inv) & 255);
      if (lane == 0) CSC[tok] = am * (1.f / 127.f);
    }
  }
}

__device__ void phase_peer_vacc(const Params& p, unsigned char* smem) {
  const int lane = threadIdx.x & 63, w = threadIdx.x >> 6;
  const int g = lane >> 3, part = lane & 7;
  const unsigned short* SELE = (const unsigned short*)(p.ws + OFF_SELE);
  const float* CSC = (const float*)(p.ws + OFF_CSC);
  for (int item = blockIdx.x; item < 256; item += gridDim.x) {
    const int x = item & 7, lb = item >> 3;
    const unsigned char* VS = p.ws + OFF_VQ + (size_t)x * 2097152 + part * 16;
    for (int t = 0; t < 128; ++t) {
      const int tok = lb * 1024 + w * 128 + t;
      const u32x4 cq = *(const u32x4*)(p.ws + OFF_CQ + (size_t)tok * 128 + g * 16);
      int eid[16];
#pragma unroll
      for (int m = 0; m < 2; ++m) {
        const u32x4 e4 = *(const u32x4*)(SELE + (size_t)tok * 128 + g * 16 + m * 8);
#pragma unroll
        for (int q = 0; q < 4; ++q) { eid[8 * m + 2 * q] = (int)(e4[q] & 0xffffu); eid[8 * m + 2 * q + 1] = (int)(e4[q] >> 16); }
      }
      u32x4 vq[16];
#pragma unroll
      for (int it = 0; it < 16; ++it) vq[it] = *(const u32x4*)(VS + (size_t)eid[it] * 128);
      int acc[16];
#pragma unroll
      for (int j = 0; j < 16; ++j) acc[j] = 0;
#pragma unroll
      for (int m = 0; m < 4; ++m) {
#pragma unroll
        for (int c4 = 0; c4 < 4; ++c4) {
          const unsigned a = vq[4 * m][c4], b = vq[4 * m + 1][c4], c = vq[4 * m + 2][c4], d = vq[4 * m + 3][c4];
          const unsigned ab_lo = __builtin_amdgcn_perm(a, b, 0x01050004u), ab_hi = __builtin_amdgcn_perm(a, b, 0x03070206u);
          const unsigned cd_lo = __builtin_amdgcn_perm(c, d, 0x01050004u), cd_hi = __builtin_amdgcn_perm(c, d, 0x03070206u);
          const unsigned col0 = __builtin_amdgcn_perm(ab_lo, cd_lo, 0x01000504u), col1 = __builtin_amdgcn_perm(ab_lo, cd_lo, 0x03020706u);
          const unsigned col2 = __builtin_amdgcn_perm(ab_hi, cd_hi, 0x01000504u), col3 = __builtin_amdgcn_perm(ab_hi, cd_hi, 0x03020706u);
          acc[4 * c4 + 0] = __builtin_amdgcn_sdot4((int)col0, (int)cq[m], acc[4 * c4 + 0], false);
          acc[4 * c4 + 1] = __builtin_amdgcn_sdot4((int)col1, (int)cq[m], acc[4 * c4 + 1], false);
          acc[4 * c4 + 2] = __builtin_amdgcn_sdot4((int)col2, (int)cq[m], acc[4 * c4 + 2], false);
          acc[4 * c4 + 3] = __builtin_amdgcn_sdot4((int)col3, (int)cq[m], acc[4 * c4 + 3], false);
        }
      }
      int* red = (int*)smem + w * 1024;
#pragma unroll
      for (int m = 0; m < 4; ++m) {
        u32x4 t4;
        t4[0] = (unsigned)acc[4 * m]; t4[1] = (unsigned)acc[4 * m + 1]; t4[2] = (unsigned)acc[4 * m + 2]; t4[3] = (unsigned)acc[4 * m + 3];
        *(u32x4*)(red + m * 256 + lane * 4) = t4;
      }
      int s0 = 0, s1 = 0;
#pragma unroll
      for (int gg = 0; gg < 8; ++gg) {
        const uint2 t2 = *(const uint2*)(red + (g >> 1) * 256 + (gg * 8 + part) * 4 + (g & 1) * 2);
        s0 += (int)t2.x;
        s1 += (int)t2.y;
      }
      const float cs = CSC[tok];
      const int col = x * 128 + part * 16 + 2 * g;
      *(unsigned*)((bf16_t*)(p.ws + OFF_QG) + (size_t)tok * 1024 + col) = pack2(cs * (float)s0, cs * (float)s1);
    }
  }
}

__device__ void phase_final_norm(const Params& p) {
  const int lane = threadIdx.x & 63, w = threadIdx.x >> 6;
  const float* mod = (const float*)(p.ws + OFF_MOD);
  const bf16_t* PB = (const bf16_t*)(p.ws + OFF_QG);
  for (int tok = blockIdx.x * 8 + w; tok < RLAT; tok += gridDim.x * 8) {
    const int bb = tok >> 12;
    float* xr = p.out + (size_t)tok * 1024;
    f32x4 v[4];
    float s = 0.f;
#pragma unroll
    for (int m = 0; m < 4; ++m) {
      const int col = (m * 64 + lane) * 4;
      v[m] = *(const f32x4*)(xr + col);
      const uint2 pk = *(const uint2*)(PB + (size_t)tok * 1024 + col);
      const f32x4 gv = *(const f32x4*)(mod + bb * 6144 + 5120 + col);
      v[m][0] += gv[0] * __uint_as_float(pk.x << 16);
      v[m][1] += gv[1] * __uint_as_float(pk.x & 0xffff0000u);
      v[m][2] += gv[2] * __uint_as_float(pk.y << 16);
      v[m][3] += gv[3] * __uint_as_float(pk.y & 0xffff0000u);
      s += v[m][0] * v[m][0] + v[m][1] * v[m][1] + v[m][2] * v[m][2] + v[m][3] * v[m][3];
    }
    s = wave_sum(s);
    const float rs = rsqrtf(s * (1.f / 1024.f) + 1e-6f);
#pragma unroll
    for (int m = 0; m < 4; ++m) {
      const int col = (m * 64 + lane) * 4;
      const f32x4 fg = *(const f32x4*)(p.final_g + col);
      f32x4 o = v[m];
      o[0] *= rs * fg[0]; o[1] *= rs * fg[1]; o[2] *= rs * fg[2]; o[3] *= rs * fg[3];
      *(f32x4*)(xr + col) = o;
    }
  }
}

constexpr size_t OFF_BAR = WS_END + 8388608;
#define XB_TMO      128
#define XB_XCNT(j)  (256  + 64 * (j))
#define XB_XSUB(j)  (1280 + 64 * (j))
#define XB_XGEN(j)  (2304 + 64 * (j))
#define XB_TOP      3328
#define XB_TOPGEN   3392
#define XCD_BAR_WORDS 3456
#define XB_SPIN_CAP (1u << 18)
#define LAS __attribute__((address_space(3)))
__device__ __forceinline__ unsigned xb_ld(unsigned* p)              { return __hip_atomic_load(p, __ATOMIC_RELAXED, __HIP_MEMORY_SCOPE_AGENT); }
__device__ __forceinline__ unsigned xb_add(unsigned* p, unsigned v) { return __hip_atomic_fetch_add(p, v, __ATOMIC_RELAXED, __HIP_MEMORY_SCOPE_AGENT); }
__device__ __forceinline__ unsigned xb_xcc_id() { return (unsigned)__builtin_amdgcn_s_getreg((3 << 11) | 20) & 0xFu; }
#define XB_SPIN(cond, bar) do { unsigned _sp = 0; while (cond) { __builtin_amdgcn_s_sleep(1); \
    if ((++_sp & 255u) == 0u) { if (xb_ld(&(bar)[XB_TMO])) break; if (_sp > XB_SPIN_CAP) { atomicAdd(&(bar)[XB_TMO], 1u); break; } } } } while (0)
struct XcdBarrier { unsigned* bar; unsigned x; volatile LAS unsigned* st; };
__device__ __forceinline__ XcdBarrier xcd_barrier_post(unsigned* bar, volatile LAS unsigned* st) {
  XcdBarrier b; b.bar = bar; b.x = xb_xcc_id(); b.st = st;
  if (threadIdx.x == 0) (void)xb_add(&bar[XB_XCNT(b.x)], 1u);
  return b;
}
__device__ __forceinline__ void xcd_barrier_complete(unsigned* bar, unsigned x, unsigned& nloc, unsigned& nx) {
  const unsigned G = gridDim.x * gridDim.y * gridDim.z;
  unsigned sum, cnt, mine, sp = 0u;
  for (;;) {
    sum = 0u; cnt = 0u; mine = 0u;
#pragma unroll
    for (unsigned j = 0; j < 16; ++j) { const unsigned c = xb_ld(&bar[XB_XCNT(j)]); sum += c; cnt += (c > 0u) ? 1u : 0u; mine = (j == x) ? c : mine; }
    if (sum == G) break;
    __builtin_amdgcn_s_sleep(1);
    if ((++sp & 255u) == 0u) { if (xb_ld(&bar[XB_TMO])) break; if (sp > XB_SPIN_CAP) { atomicAdd(&bar[XB_TMO], 1u); break; } }
  }
  nloc = mine > 0u ? mine : 1u; nx = cnt > 0u ? cnt : 1u;
}
__device__ __forceinline__ void xcd_barrier(const XcdBarrier& b) {
  asm volatile("s_waitcnt vmcnt(0)" ::: "memory");
  __syncthreads();
  if (threadIdx.x == 0) {
    unsigned* bar = b.bar;
    __builtin_amdgcn_s_waitcnt(0);
    unsigned nloc = b.st[0], nx = b.st[1];
    if (nloc == 0u) { xcd_barrier_complete(bar, b.x, nloc, nx); b.st[0] = nloc; b.st[1] = nx; }
    const unsigned old = xb_add(&bar[XB_XSUB(b.x)], 1u);
    const unsigned gen = old / nloc;
    if (old + 1u == (gen + 1u) * nloc) {
      __builtin_amdgcn_fence(__ATOMIC_RELEASE, "agent");
      asm volatile("s_waitcnt vmcnt(0)" ::: "memory");
      const unsigned og = xb_add(&bar[XB_TOP], 1u);
      const unsigned tg = og / nx;
      if (og + 1u == (tg + 1u) * nx) xb_add(&bar[XB_TOPGEN], 1u);
      else XB_SPIN(xb_ld(&bar[XB_TOPGEN]) == tg, bar);
      __builtin_amdgcn_fence(__ATOMIC_ACQUIRE, "agent");
      xb_add(&bar[XB_XGEN(b.x)], 1u);
      asm volatile("s_waitcnt vmcnt(0)" ::: "memory");
    } else {
      XB_SPIN(xb_ld(&bar[XB_XGEN(b.x)]) == gen, bar);
      __builtin_amdgcn_fence(__ATOMIC_ACQUIRE, "agent");
      asm volatile("s_waitcnt vmcnt(0)" ::: "memory");
    }
  }
  __syncthreads();
}

#ifndef PROBE_REP
#define PROBE_REP 0
#endif
__global__ void __launch_bounds__(NT) mega(Params p) {
  extern __shared__ __align__(16) unsigned char smem[];
  cg::grid_group grid = cg::this_grid();
  volatile LAS unsigned* xst = (volatile LAS unsigned*)(smem + LDS_BYTES - 16);
  if (threadIdx.x == 0) { xst[0] = 0u; xst[1] = 0u; }
  __syncthreads();
  const XcdBarrier xbar = xcd_barrier_post((unsigned*)(p.ws + OFF_BAR), xst);
  if (p.ph_lo > 1000) grid.sync();
#define PH(i) (p.ph_lo <= (i) && (i) < p.ph_hi)
#define SYNC(i) if (PH(i) && PH((i) + 1)) xcd_barrier(xbar);
#define RUN(i, body)                                         \
  if (PH(i)) {                                               \
    const int nrep_ = 1 + ((p.rep_mask >> (i)) & 1);         \
    for (int rep_ = 0; rep_ < nrep_; ++rep_) {               \
      if (rep_) xcd_barrier(xbar);                           \
      body;                                                  \
    }                                                        \
  }                                                          \
  SYNC(i)
#define RUN1(i, body) if (PH(i)) { body; } SYNC(i)
  RUN(0, phase0(p, smem))
  RUN(1, norm_mod_rows(p.x, p.ctx, RALL, p.norm1_g, (const float*)(p.ws + OFF_MOD), 0, 1024, (bf16_t*)(p.ws + OFF_KC)))
  RUN(2, phase_inproj(p, smem))
  RUN1(3, {
    u32x4 pr[7];
    float pf[5];
    int item = blockIdx.x;
    if (item < 2176) prepass_preload(p, item, pr, pf);
    for (; item < 2176; item += gridDim.x) gdn_prepass_item(p, item, item + gridDim.x, smem, pr, pf); })
  RUN1(4, {
    const int item = blockIdx.x;
    if (item < 128) gdn_seq_item(p, item, smem);
    else if (item < 256) rglru_item(p, item - 128, smem); })
  RUN(5, { phase_ya(p); phase_quant_uv(p); })
  RUN(6, phase_outproj(p, smem))
  RUN(7, norm_mod_rows(p.out, p.out, RLAT, p.norm2_g, (const float*)(p.ws + OFF_MOD), 3072, 4096, (bf16_t*)(p.ws + OFF_PRG)))
  RUN(8, phase_peer_query(p, smem))
  RUN1(9, phase_peer_select(p, smem))
  RUN1(10, phase_peer_udot(p))
  RUN1(11, phase_peer_coef(p))
  RUN1(12, phase_peer_vacc(p, smem))
  if (PH(13)) phase_final_norm(p);
}

extern "C" void kernel_launch(void* const* d_in, const int* in_sizes, int n_in, void* d_out, int out_size,
                              void* d_ws, size_t ws_size, hipStream_t stream) {
  static int grid_blocks = 0;
  if (grid_blocks == 0) {
    if (ws_size < OFF_BAR + 16384) { fprintf(stderr, "workspace too small: %zu < %zu\n", ws_size, (size_t)WS_END); grid_blocks = -1; return; }
    int dev = 0, cus = 0, per_cu = 0;
    hipGetDevice(&dev);
    hipDeviceGetAttribute(&cus, hipDeviceAttributeMultiprocessorCount, dev);
    if (hipFuncSetAttribute((const void*)mega, hipFuncAttributeMaxDynamicSharedMemorySize, LDS_BYTES) != hipSuccess) {
      fprintf(stderr, "hipFuncSetAttribute failed\n"); grid_blocks = -1; return;
    }
    hipOccupancyMaxActiveBlocksPerMultiprocessor(&per_cu, (const void*)mega, NT, LDS_BYTES);
    if (per_cu < 1) { fprintf(stderr, "occupancy query says %d\n", per_cu); per_cu = 1; }
    (void)hipGetLastError();
    grid_blocks = cus * per_cu;
    if (grid_blocks < 256) { fprintf(stderr, "grid %d < 256: scan phase needs 256 resident blocks\n", grid_blocks); grid_blocks = -1; return; }
  }
  if (grid_blocks < 0) return;
  Params p{};
  const float** pp = (const float**)&p;
  for (int i = 0; i < 24; ++i) pp[i] = (const float*)d_in[i];
  p.out = (float*)d_out;
  p.ws = (unsigned char*)d_ws;
  p.ph_lo = 0;
  p.ph_hi = 14;
  p.rep_mask = PROBE_REP;
  if (hipMemsetAsync((char*)d_ws + OFF_BAR, 0, 16384, stream) != hipSuccess) { fprintf(stderr, "barrier memset failed\n"); return; }
  void* args[] = {&p};
  hipError_t e = hipLaunchCooperativeKernel((const void*)mega, dim3(grid_blocks), dim3(NT), args, LDS_BYTES, stream);
  if (e != hipSuccess) fprintf(stderr, "cooperative launch failed: %s (grid %d)\n", hipGetErrorString(e), grid_blocks);
}
```
